# Optimizing an MI355X kernel written in HIP

```python
import jax, jax.numpy as jnp
from jax import lax
import numpy as np

D_MODEL = 1024
BATCH = 32
SEQ = 2048
DEPTH = 4

ATT_PATTERNS = ((128, 1), (512, 4), (2048, 16))
N_ATT_GROUPS = 3
ATT_HEADS_PER_GROUP = 4
ATT_HEAD_DIM = 128
ATT_QKV = N_ATT_GROUPS * ATT_HEADS_PER_GROUP * ATT_HEAD_DIM
ATT_OUT = ATT_HEADS_PER_GROUP * ATT_HEAD_DIM
ATT_BLOCK = 128
RET_HEADS = 4
RET_QK_DIM = D_MODEL // RET_HEADS
RET_V_DIM = D_MODEL // RET_HEADS
RET_QK = RET_HEADS * RET_QK_DIM
RET_WIDTH = RET_HEADS * RET_V_DIM
RET_CHUNK = 128
ROPE_BASE = 10000.0
EPS = 1e-6
NEG_INF = -1e30
SPLIT_SIZES = (ATT_QKV, ATT_QKV, ATT_QKV, ATT_OUT, RET_QK, RET_QK, RET_WIDTH, RET_WIDTH, D_MODEL, D_MODEL)
IN_WIDTH = sum(SPLIT_SIZES)
SPLIT_POINTS = tuple(int(v) for v in np.cumsum(SPLIT_SIZES)[:-1])

kernel_name = "hybrid_dilated_attn_retention_adaln"


def rmsnorm(x, w):
    xf = x.astype(jnp.float32)
    y = xf * lax.rsqrt(jnp.mean(xf * xf, axis=-1, keepdims=True) + EPS)
    return (y * w.astype(jnp.float32)).astype(x.dtype)


def dilated_window_attention(q, k, v, window, dil):
    B, S, G, Dh = q.shape
    L = S // dil
    span = window // dil
    blk = min(ATT_BLOCK, L)
    nb = -(-L // blk)
    Lp = nb * blk

    def to_sub(t):
        t = t.astype(jnp.float32).reshape(B, L, dil, G, Dh).transpose(0, 2, 3, 1, 4)
        t = jnp.pad(t, ((0, 0), (0, 0), (0, 0), (0, Lp - L), (0, 0)))
        return t.reshape(B, dil, G, nb, blk, Dh)

    def with_prev(t):
        prev = jnp.pad(t, ((0, 0), (0, 0), (0, 0), (1, 0), (0, 0), (0, 0)))[:, :, :, :-1]
        return jnp.concatenate([prev, t], axis=-2)

    qs = to_sub(q)
    kk = with_prev(to_sub(k))
    vv = with_prev(to_sub(v))
    s = jnp.einsum('bcgnqd,bcgnkd->bcgnqk', qs, kk) * (Dh ** -0.5)
    qi = jnp.arange(nb)[:, None, None] * blk + jnp.arange(blk)[None, :, None]
    ki = jnp.arange(nb)[:, None, None] * blk - blk + jnp.arange(2 * blk)[None, None, :]
    dist = qi - ki
    valid = (ki >= 0) & (dist >= 0) & (dist <= span)
    s = jnp.where(valid, s, NEG_INF)
    m = jnp.max(s, axis=-1, keepdims=True)
    p = jnp.exp(s - m)
    l = jnp.sum(p, axis=-1, keepdims=True)
    o = jnp.einsum('bcgnqk,bcgnkd->bcgnqd', p, vv) / l
    lse = (m + jnp.log(l))[..., 0]
    o = o.reshape(B, dil, G, Lp, Dh)[:, :, :, :L].transpose(0, 3, 1, 2, 4).reshape(B, S, G, Dh)
    lse = lse.reshape(B, dil, G, Lp)[..., :L].transpose(0, 3, 1, 2).reshape(B, S, G)
    return o, lse


def rotary(t, positions):
    d = t.shape[-1]
    half = d // 2
    theta = ROPE_BASE ** (-jnp.arange(half, dtype=jnp.float32) / half)
    ang = positions.astype(jnp.float32)[..., None] * theta
    cos, sin = jnp.cos(ang)[:, :, None, :], jnp.sin(ang)[:, :, None, :]
    tf = t.astype(jnp.float32)
    t1, t2 = tf[..., :half], tf[..., half:]
    return jnp.concatenate([t1 * cos - t2 * sin, t2 * cos + t1 * sin], axis=-1)


def retention(q, k, v, positions, gn_w):
    B, S, H, dk = q.shape
    dv = v.shape[-1]
    q = rotary(q, positions)
    k = rotary(k, positions) * (dk ** -0.5)
    C = RET_CHUNK
    N = S // C

    def chunks(t):
        return t.astype(jnp.float32).reshape(B, N, C, H, t.shape[-1]).transpose(1, 0, 3, 2, 4)

    log_g = jnp.log1p(-jnp.exp2(-5.0 - jnp.arange(H, dtype=jnp.float32)))
    idx = jnp.arange(C, dtype=jnp.float32)
    diff = idx[:, None] - idx[None, :]
    inner_decay = jnp.where(diff >= 0, jnp.exp(log_g[:, None, None] * jnp.maximum(diff, 0.0)), 0.0)
    q_decay = jnp.exp(log_g[:, None] * (idx + 1.0))
    k_decay = jnp.exp(log_g[:, None] * (C - 1.0 - idx))
    chunk_decay = jnp.exp(log_g * C)

    def step(state, qkv):
        qc, kc, vc = qkv
        att = jnp.einsum('bhnd,bhmd->bhnm', qc, kc) * inner_decay
        out = (jnp.einsum('bhnm,bhme->bhne', att, vc)
               + jnp.einsum('bhnd,bhde->bhne', qc, state) * q_decay[:, :, None])
        state = (state * chunk_decay[:, None, None]
                 + jnp.einsum('bhmd,bhme->bhde', kc * k_decay[:, :, None], vc))
        return state, out

    state0 = jnp.zeros((B, H, dk, dv), jnp.float32)
    _, out = lax.scan(step, state0, (chunks(q), chunks(k), chunks(v)))
    out = out.transpose(1, 0, 3, 2, 4).reshape(B, S, H, dv)
    mu = jnp.mean(out, axis=-1, keepdims=True)
    var = jnp.mean(jnp.square(out - mu), axis=-1, keepdims=True)
    out = (out - mu) * lax.rsqrt(var + EPS)
    return out.reshape(B, S, H * dv) * gn_w.astype(jnp.float32)


def hybrid_layer(x, c_act, positions, norm_w, w_ada, b_ada, w_in, ret_gn_w, w_proj_attn, w_proj_ret, w_out):
    B, S, D = x.shape
    mod = c_act @ w_ada + b_ada
    shift, scale, gate = jnp.split(mod, 3, axis=-1)
    h = rmsnorm(x, norm_w) * (1.0 + scale[:, None, :]) + shift[:, None, :]
    proj = h @ w_in
    qa, ka, va, za, qr, kr, vr, zr, ga, gr = jnp.split(proj, SPLIT_POINTS, axis=-1)

    att_shape = (B, S, N_ATT_GROUPS, ATT_HEADS_PER_GROUP, ATT_HEAD_DIM)
    qa, ka, va = qa.reshape(att_shape), ka.reshape(att_shape), va.reshape(att_shape)
    outs, lses = [], []
    for g, (window, dil) in enumerate(ATT_PATTERNS):
        o, lse = dilated_window_attention(qa[:, :, g], ka[:, :, g], va[:, :, g], window, dil)
        outs.append(o)
        lses.append(lse)
    wts = jax.nn.softmax(jnp.stack(lses, axis=0), axis=0)
    o_att = jnp.sum(wts[..., None] * jnp.stack(outs, axis=0), axis=0)
    y_att = o_att.reshape(B, S, ATT_OUT).astype(x.dtype) * jax.nn.silu(za)

    ret_qk = (B, S, RET_HEADS, RET_QK_DIM)
    o_ret = retention(qr.reshape(ret_qk), kr.reshape(ret_qk), vr.reshape(B, S, RET_HEADS, RET_V_DIM),
                      positions, ret_gn_w)
    y_ret = o_ret.astype(x.dtype) * jax.nn.silu(zr)

    merged = jax.nn.sigmoid(ga) * (y_att @ w_proj_attn) + jax.nn.sigmoid(gr) * (y_ret @ w_proj_ret)
    return x + gate[:, None, :] * (merged @ w_out)


def setup_inputs(seed: int = 0) -> dict:
    key = jax.random.key(seed)
    ks = jax.random.split(key, 12)
    f32 = jnp.float32
    D = D_MODEL
    x = jax.random.normal(ks[0], (BATCH, SEQ, D), f32)
    c = jax.random.normal(ks[1], (BATCH, D), f32)
    positions = jnp.tile(jnp.arange(SEQ, dtype=jnp.int32)[None, :], (BATCH, 1))
    norm_w = 1.0 + 0.01 * jax.random.normal(ks[2], (DEPTH, D), f32)
    w_ada = 0.5 * jax.random.normal(ks[3], (DEPTH, D, 3 * D), f32) * D ** -0.5
    b_ada = 0.01 * jax.random.normal(ks[4], (DEPTH, 3 * D), f32)
    w_in = jax.random.normal(ks[5], (DEPTH, D, IN_WIDTH), f32) * D ** -0.5
    ret_gn_w = 1.0 + 0.01 * jax.random.normal(ks[6], (DEPTH, RET_WIDTH), f32)
    w_proj_attn = jax.random.normal(ks[7], (DEPTH, ATT_OUT, D), f32) * ATT_OUT ** -0.5
    w_proj_ret = jax.random.normal(ks[8], (DEPTH, RET_WIDTH, D), f32) * RET_WIDTH ** -0.5
    w_out = jax.random.normal(ks[9], (DEPTH, D, D), f32) * D ** -0.5
    final_norm_w = 1.0 + 0.01 * jax.random.normal(ks[10], (D,), f32)
    return {"x": x, "c": c, "positions": positions, "norm_w": norm_w, "w_ada": w_ada, "b_ada": b_ada,
            "w_in": w_in, "ret_gn_w": ret_gn_w, "w_proj_attn": w_proj_attn, "w_proj_ret": w_proj_ret,
            "w_out": w_out, "final_norm_w": final_norm_w}


def reference(x, c, positions, norm_w, w_ada, b_ada, w_in, ret_gn_w, w_proj_attn, w_proj_ret, w_out, final_norm_w):
    c_act = jax.nn.silu(c)
    for l in range(DEPTH):
        x = hybrid_layer(x, c_act, positions, norm_w[l], w_ada[l], b_ada[l], w_in[l], ret_gn_w[l],
                         w_proj_attn[l], w_proj_ret[l], w_out[l])
    return rmsnorm(x, final_norm_w)
```

```cpp
#include <hip/hip_runtime.h>
#include <cstdio>
#include <cstdint>

#ifndef MK_FUSED
#define MK_FUSED 1
#endif

namespace pg8 {
#define PG8_LAS __attribute__((address_space(3)))
typedef unsigned short bf16_t;
typedef short bf16x8 __attribute__((ext_vector_type(8)));
typedef float f32x4 __attribute__((ext_vector_type(4)));
typedef unsigned u32x4 __attribute__((ext_vector_type(4)));
constexpr int BM = 256, BK = 64, HALF = 128, HTB = HALF * BK * 2  , STAGE_BYTES = 8 * HTB, NXCD = 8, WGM = 8;

__host__ __device__ __forceinline__ int lds_byte(int r, int c) { const int st = (r >> 4) * 2 + (c >> 5), rr = r & 15, cc = c & 31, ob = rr * 64 + cc * 2; return st * 1024 + (ob ^ (((ob >> 9) & 1) << 5)); }
__host__ __device__ __forceinline__ void stage_rc(int b, int& R, int& C) { const int st = b / 1024, sb = b % 1024, swz = sb ^ (((sb >> 9) & 1) << 5); R = (st >> 1) * 16 + swz / 64; C = (st & 1) * 32 + (swz % 64) / 2; }
__host__ __device__ __forceinline__ int perm32(int rho) { const int n = rho >> 4, i = rho & 15; return 8 * (i >> 2) + 4 * n + (i & 3); }

struct Unit { int pm, pn; };
struct Gemm { const bf16_t* A; const bf16_t* Bt; };

struct StaticOrder {
    int nM, nN, nwg, G, c;
    __host__ __device__ void init(int M, int N, int G_, int c_) { nM = M / BM; nN = N / BM; nwg = nM * nN; G = G_; c = c_; }
    __host__ __device__ bool next(int i, Unit& u) const {
        const long L = (long)i * G + c; if (L >= nwg) return false;
        int wgid = (int)L; { const int q = nwg / NXCD, r = nwg % NXCD, xcd = wgid % NXCD, off = wgid / NXCD; wgid = (xcd < r ? xcd * (q + 1) : r * (q + 1) + (xcd - r) * q) + off; }
        const int nig = WGM * nN, gid = wgid / nig, fm = gid * WGM, gsz = (nM - fm) < WGM ? (nM - fm) : WGM;
        u.pm = fm + ((wgid % nig) % gsz); u.pn = (wgid % nig) / gsz; return true;
    }
    __device__ __forceinline__ void a_ready(const Unit&) const {}
    __device__ __forceinline__ void done(const Unit&) const {}
};

__device__ __forceinline__ unsigned cvt_pk_bf16(float lo, float hi) { unsigned r; asm volatile("v_cvt_pk_bf16_f32 %0, %1, %2" : "=v"(r) : "v"(lo), "v"(hi)); return r; }
__device__ __forceinline__ float bf_lo(unsigned w) { return __uint_as_float(w << 16); }
__device__ __forceinline__ float bf_hi(unsigned w) { return __uint_as_float(w & 0xffff0000u); }
__device__ __forceinline__ float sigmoidf_(float x) { return __builtin_amdgcn_rcpf(1.0f + __builtin_amdgcn_exp2f(-1.4426950408889634f * x)); }

constexpr int LDP = 11264;
constexpr int C_QA = 0, C_KA = 1536, C_VA = 3072, C_ZA = 4608, C_QR = 5120, C_KR = 6144, C_VR = 7168, C_ZR = 8192, C_GA = 9216, C_GR = 10240;

struct EpiProj {
    static constexpr bool PERM = true, AFTER_DRAIN = false;
    bf16_t* P; const int* pos; int tok0;
    __device__ __forceinline__ void operator()(const f32x4 (&acc)[2][2][4][2], const Unit& u, int wr, int wc, int fr, int fq) const {
        const int pn = u.pn;
        const int row0 = u.pm * BM + wr * 64 + fr, col0 = pn * BM + wc * 32 + 8 * fq;
        const int mode = (pn >= 20 && pn < 24) ? 3 : (pn >= 24 && pn < 28) ? 4 : ((pn == 18) || (pn == 19) || (pn >= 32 && pn < 36)) ? 1 : (pn >= 36) ? 2 : 0;
        if (mode < 3) {
#pragma unroll
            for (int ai = 0; ai < 2; ++ai)
#pragma unroll
                for (int m = 0; m < 4; ++m) { bf16_t* rowp = P + (size_t)(row0 + ai * HALF + m * 16) * LDP + col0;
#pragma unroll
                    for (int bj = 0; bj < 2; ++bj) { f32x4 v0 = acc[ai][bj][m][0], v1 = acc[ai][bj][m][1];
                        if (mode == 1) {
#pragma unroll
                            for (int j = 0; j < 4; ++j) { v0[j] = v0[j] * sigmoidf_(v0[j]); v1[j] = v1[j] * sigmoidf_(v1[j]); } }
                        if (mode == 2) {
#pragma unroll
                            for (int j = 0; j < 4; ++j) { v0[j] = sigmoidf_(v0[j]); v1[j] = sigmoidf_(v1[j]); } }
                        u32x4 w; w.x = cvt_pk_bf16(v0[0], v0[1]); w.y = cvt_pk_bf16(v0[2], v0[3]); w.z = cvt_pk_bf16(v1[0], v1[1]); w.w = cvt_pk_bf16(v1[2], v1[3]);
                        *(u32x4*)(rowp + bj * HALF) = w; } }
        } else {
            const int h = pn & 3;
            const float lg = __builtin_log2f(1.0f - __builtin_amdgcn_exp2f(-5.0f - (float)h));
            float irev[2][4];
#pragma unroll
            for (int n = 0; n < 2; ++n)
#pragma unroll
                for (int j = 0; j < 4; ++j) { const int i = wc * 32 + 8 * fq + 4 * n + j;
                    irev[n][j] = __builtin_amdgcn_exp2f(-(float)i * (13.287712379549449f / 128.0f)) * 0.15915494309189535f; }
#pragma unroll
            for (int ai = 0; ai < 2; ++ai)
#pragma unroll
                for (int m = 0; m < 4; ++m) { const int row = row0 + ai * HALF + m * 16; bf16_t* rowp = P + (size_t)row * LDP + col0;
                    const float p = (float)pos[row]; const int ic = (tok0 + row) & 127;
                    const float dec = (mode == 3) ? __builtin_amdgcn_exp2f((float)(ic - 127) * lg) : __builtin_amdgcn_exp2f((float)(127 - ic) * lg) * 0.0625f;
                    f32x4 o1[2], o2[2];
#pragma unroll
                    for (int n = 0; n < 2; ++n)
#pragma unroll
                        for (int j = 0; j < 4; ++j) { const float rv = __builtin_amdgcn_fractf(p * irev[n][j]);
                            const float sn = __builtin_amdgcn_sinf(rv), cs = __builtin_amdgcn_cosf(rv);
                            const float t1 = acc[ai][0][m][n][j], t2 = acc[ai][1][m][n][j];
                            o1[n][j] = (t1 * cs - t2 * sn) * dec; o2[n][j] = (t2 * cs + t1 * sn) * dec; }
                    u32x4 w; w.x = cvt_pk_bf16(o1[0][0], o1[0][1]); w.y = cvt_pk_bf16(o1[0][2], o1[0][3]); w.z = cvt_pk_bf16(o1[1][0], o1[1][1]); w.w = cvt_pk_bf16(o1[1][2], o1[1][3]);
                    *(u32x4*)(rowp) = w;
                    w.x = cvt_pk_bf16(o2[0][0], o2[0][1]); w.y = cvt_pk_bf16(o2[0][2], o2[0][3]); w.z = cvt_pk_bf16(o2[1][0], o2[1][1]); w.w = cvt_pk_bf16(o2[1][2], o2[1][3]);
                    *(u32x4*)(rowp + HALF) = w;
                    asm volatile("" ::: "memory"); __builtin_amdgcn_sched_barrier(0); }
        }
    }
};
template <int STEP> struct EpiGate {
    static constexpr bool PERM = true, AFTER_DRAIN = false;
    bf16_t* P;
    __device__ __forceinline__ void operator()(const f32x4 (&acc)[2][2][4][2], const Unit& u, int wr, int wc, int fr, int fq) const {
        const int row0 = u.pm * BM + wr * 64 + fr, col0 = u.pn * BM + wc * 32 + 8 * fq;
#pragma unroll
        for (int ai = 0; ai < 2; ++ai)
#pragma unroll
            for (int m = 0; m < 4; ++m) { bf16_t* rowp = P + (size_t)(row0 + ai * HALF + m * 16) * LDP + col0;
#pragma unroll
                for (int bj = 0; bj < 2; ++bj) { const f32x4 a0 = acc[ai][bj][m][0], a1 = acc[ai][bj][m][1];
                    const u32x4 g = *(const u32x4*)(rowp + C_GA + bj * HALF);
                    f32x4 v0, v1;
                    if (STEP == 0) { v0 = (f32x4){bf_lo(g.x) * a0[0], bf_hi(g.x) * a0[1], bf_lo(g.y) * a0[2], bf_hi(g.y) * a0[3]};
                                     v1 = (f32x4){bf_lo(g.z) * a1[0], bf_hi(g.z) * a1[1], bf_lo(g.w) * a1[2], bf_hi(g.w) * a1[3]}; }
                    else { const u32x4 r = *(const u32x4*)(rowp + C_GR + bj * HALF);
                        v0 = (f32x4){bf_lo(g.x) + bf_lo(r.x) * a0[0], bf_hi(g.x) + bf_hi(r.x) * a0[1], bf_lo(g.y) + bf_lo(r.y) * a0[2], bf_hi(g.y) + bf_hi(r.y) * a0[3]};
                        v1 = (f32x4){bf_lo(g.z) + bf_lo(r.z) * a1[0], bf_hi(g.z) + bf_hi(r.z) * a1[1], bf_lo(g.w) + bf_lo(r.w) * a1[2], bf_hi(g.w) + bf_hi(r.w) * a1[3]}; }
                    u32x4 w; w.x = cvt_pk_bf16(v0[0], v0[1]); w.y = cvt_pk_bf16(v0[2], v0[3]); w.z = cvt_pk_bf16(v1[0], v1[1]); w.w = cvt_pk_bf16(v1[2], v1[3]);
                    *(u32x4*)(rowp + C_GA + bj * HALF) = w; }
                asm volatile("" ::: "memory"); }
    }
};
struct EpiOut {
    static constexpr bool PERM = false, AFTER_DRAIN = false;
    const float* xin; float* xout; const float* gate; int tok0;
    __device__ __forceinline__ void operator()(const f32x4 (&acc)[2][2][4][2], const Unit& u, int wr, int wc, int fr, int fq) const {
        const int row0 = u.pm * BM + wr * 64 + fr, col0 = u.pn * BM + wc * 32 + 4 * fq;
        const int b = (tok0 + u.pm * BM) >> 11;
        f32x4 gv[2][2];
#pragma unroll
        for (int bj = 0; bj < 2; ++bj)
#pragma unroll
            for (int n = 0; n < 2; ++n) gv[bj][n] = *(const f32x4*)(gate + (size_t)b * 3072 + col0 + bj * HALF + n * 16);
#pragma unroll
        for (int ai = 0; ai < 2; ++ai)
#pragma unroll
            for (int m = 0; m < 4; ++m) { const size_t off = (size_t)(tok0 + row0 + ai * HALF + m * 16) * 1024 + col0;
#pragma unroll
                for (int bj = 0; bj < 2; ++bj)
#pragma unroll
                    for (int n = 0; n < 2; ++n) { const f32x4 xv = *(const f32x4*)(xin + off + bj * HALF + n * 16);
                        *(f32x4*)(xout + off + bj * HALF + n * 16) = xv + gv[bj][n] * acc[ai][bj][m][n]; }
                asm volatile("" ::: "memory"); }
    }
};

template <class Epi, class Sched, bool ALIGN_EPI, bool SP2, int KC, int LDA, int LDB>
__device__ __forceinline__ void gemm_phase(PG8_LAS unsigned char* lds, const Gemm g, const Sched& S, const Epi& E) {
    int tid_ = threadIdx.x; asm volatile("" : "+v"(tid_));
    const int tid = tid_, wid = __builtin_amdgcn_readfirstlane(tid >> 6), lane = tid & 63, wr = wid >> 2, wc = wid & 3, fr = lane & 15, fq = lane >> 4;
    constexpr int K = KC, nt = K / BK;
    unsigned voffA[2], voffB[2];
#pragma unroll
    for (int i = 0; i < 2; ++i) { int R, C; stage_rc(tid * 16 + i * 8192, R, C); const int Rb = Epi::PERM ? ((R & ~31) + perm32(R & 31)) : R;
        voffA[i] = (unsigned)(R * LDA + C) * 2u; voffB[i] = (unsigned)(Rb * LDB + C) * 2u; }
    constexpr size_t kstep = (size_t)(BK * 2);
    constexpr size_t hstepA = (size_t)HALF * LDA * 2, hstepB = (size_t)HALF * LDB * 2;
    constexpr size_t tstepA = 2 * hstepA, tstepB = 2 * hstepB;
    const unsigned ldsw = (unsigned)wid * 1024u;
    const int aoff = lds_byte(wr * 64 + fr, fq * 8), boff = lds_byte(wc * 32 + fr, fq * 8);
#define PG8_SA(b, h) (((b) * 2 + (h)) * HTB)
#define PG8_SB(b, h) ((4 + (b) * 2 + (h)) * HTB)
#define PG8_STAGE(bufoff, gbase, voff) do { _Pragma("unroll") for (int _i = 0; _i < 2; ++_i) \
        __builtin_amdgcn_global_load_lds((const unsigned*)((const char*)(gbase) + (voff)[_i]), (PG8_LAS unsigned*)(lds + (bufoff) + ldsw + _i * 8192), 16, 0, 0); } while (0)
#define PG8_LDA(dst, b, h) do { _Pragma("unroll") for (int m = 0; m < 4; ++m) _Pragma("unroll") for (int k = 0; k < 2; ++k) dst[m][k] = *(const PG8_LAS bf16x8*)(lds + PG8_SA(b, h) + aoff + m * 2048 + k * 1024); } while (0)
#define PG8_LDB(dst, b, h) do { _Pragma("unroll") for (int n = 0; n < 2; ++n) _Pragma("unroll") for (int k = 0; k < 2; ++k) dst[n][k] = *(const PG8_LAS bf16x8*)(lds + PG8_SB(b, h) + boff + n * 2048 + k * 1024); } while (0)
#define PG8_MMA(ai, bj, At, Bt) do { __builtin_amdgcn_s_setprio(1); _Pragma("unroll") for (int m = 0; m < 4; ++m) _Pragma("unroll") for (int n = 0; n < 2; ++n) _Pragma("unroll") for (int k = 0; k < 2; ++k) \
        acc[ai][bj][m][n] = __builtin_amdgcn_mfma_f32_16x16x32_bf16(Bt[n][k], At[m][k], acc[ai][bj][m][n], 0, 0, 0); __builtin_amdgcn_s_setprio(0); } while (0)
#define PG8_WAIT_V(n) asm volatile("s_waitcnt vmcnt(" #n ")" ::: "memory")
#define PG8_WAIT_L(n) asm volatile("s_waitcnt lgkmcnt(" #n ")" ::: "memory")
#define PG8_BAR __builtin_amdgcn_s_barrier()
#define PG8_SCHED __builtin_amdgcn_sched_barrier(0)
    Unit cur, nxt; int ui = 0;
    if (!S.next(0, cur)) return;
    f32x4 acc[2][2][4][2];
#pragma unroll
    for (int a = 0; a < 2; ++a)
#pragma unroll
        for (int b = 0; b < 2; ++b)
#pragma unroll
            for (int m = 0; m < 4; ++m)
#pragma unroll
                for (int n = 0; n < 2; ++n) acc[a][b][m][n] = (f32x4){0.f, 0.f, 0.f, 0.f};
    bf16x8 At[4][2], B0[2][2], B1[2][2];
    const char* cA = (const char*)g.A + (size_t)cur.pm * tstepA; const char* cB = (const char*)g.Bt + (size_t)cur.pn * tstepB;
    S.a_ready(cur);
    if constexpr (SP2) {
        PG8_STAGE(PG8_SB(0, 0), cB, voffB); PG8_STAGE(PG8_SB(0, 1), cB + hstepB, voffB); PG8_STAGE(PG8_SA(0, 0), cA, voffA); PG8_STAGE(PG8_SA(0, 1), cA + hstepA, voffA);
        if (wr == 1) PG8_BAR;
        PG8_WAIT_V(2); PG8_BAR;
        PG8_STAGE(PG8_SB(1, 0), cB + kstep, voffB); PG8_STAGE(PG8_SA(1, 0), cA + kstep, voffA); PG8_STAGE(PG8_SB(1, 1), cB + hstepB + kstep, voffB);
        PG8_WAIT_V(6); PG8_BAR;
    } else {
        PG8_STAGE(PG8_SB(0, 0), cB, voffB); PG8_STAGE(PG8_SA(0, 0), cA, voffA); PG8_STAGE(PG8_SB(0, 1), cB + hstepB, voffB); PG8_STAGE(PG8_SA(0, 1), cA + hstepA, voffA);
        if (wr == 1) PG8_BAR;
        PG8_WAIT_V(4); PG8_BAR;
        PG8_STAGE(PG8_SB(1, 0), cB + kstep, voffB); PG8_STAGE(PG8_SA(1, 0), cA + kstep, voffA); PG8_STAGE(PG8_SB(1, 1), cB + hstepB + kstep, voffB);
        PG8_WAIT_V(6); PG8_BAR;
    }
    for (;;) {
        const bool has_next = S.next(ui + 1, nxt);
        const char* nA = has_next ? (const char*)g.A + (size_t)nxt.pm * tstepA : cA; const char* nB = has_next ? (const char*)g.Bt + (size_t)nxt.pn * tstepB : cB;
        for (int t = 0; t < nt; t += 2) {
            const bool last = (t == nt - 2);
            const char* a1 = cA + (size_t)(t + 1) * kstep;
            const char* a2 = last ? nA : cA + (size_t)(t + 2) * kstep; const char* b2 = last ? nB : cB + (size_t)(t + 2) * kstep;
            const char* a3 = a2 + kstep; const char* b3 = b2 + kstep;
            if (last && has_next) S.a_ready(nxt);
            if constexpr (SP2) {
            PG8_LDB(B0, 0, 0); PG8_LDB(B1, 0, 1); PG8_SCHED; PG8_LDA(At, 0, 0); PG8_STAGE(PG8_SA(1, 1), a1 + hstepA, voffA);
            PG8_WAIT_V(8); PG8_WAIT_L(0); PG8_BAR; PG8_MMA(0, 0, At, B0); PG8_MMA(0, 1, At, B1); PG8_BAR; PG8_SCHED;
            PG8_LDA(At, 0, 1); PG8_STAGE(PG8_SB(0, 0), b2, voffB); PG8_STAGE(PG8_SB(0, 1), b2 + hstepB, voffB); PG8_STAGE(PG8_SA(0, 0), a2, voffA);
            PG8_WAIT_V(8); PG8_WAIT_L(0); PG8_BAR; PG8_MMA(1, 0, At, B0); PG8_MMA(1, 1, At, B1); PG8_BAR; PG8_SCHED;
            PG8_LDB(B0, 1, 0); PG8_LDB(B1, 1, 1); PG8_SCHED; PG8_LDA(At, 1, 0); PG8_STAGE(PG8_SA(0, 1), a2 + hstepA, voffA);
            PG8_WAIT_V(8); PG8_WAIT_L(0); PG8_BAR; PG8_MMA(0, 0, At, B0); PG8_MMA(0, 1, At, B1); PG8_BAR; PG8_SCHED;
            PG8_LDA(At, 1, 1); PG8_STAGE(PG8_SB(1, 0), b3, voffB); PG8_STAGE(PG8_SB(1, 1), b3 + hstepB, voffB); PG8_STAGE(PG8_SA(1, 0), a3, voffA);
            PG8_WAIT_V(8); PG8_WAIT_L(0); PG8_BAR; PG8_MMA(1, 0, At, B0); PG8_MMA(1, 1, At, B1); PG8_BAR; PG8_SCHED;
            } else {
            PG8_LDB(B0, 0, 0); PG8_SCHED; PG8_LDA(At, 0, 0); PG8_STAGE(PG8_SA(1, 1), a1 + hstepA, voffA);
            PG8_WAIT_L(8); PG8_BAR; PG8_WAIT_L(0); PG8_MMA(0, 0, At, B0); PG8_BAR; PG8_SCHED;
            PG8_LDB(B1, 0, 1); PG8_STAGE(PG8_SB(0, 0), b2, voffB);
            PG8_BAR; PG8_WAIT_L(0); PG8_MMA(0, 1, At, B1); PG8_BAR;
            PG8_LDA(At, 0, 1); PG8_STAGE(PG8_SA(0, 0), a2, voffA);
            PG8_BAR; PG8_WAIT_L(0); PG8_MMA(1, 0, At, B0); PG8_BAR; PG8_SCHED;
            PG8_STAGE(PG8_SB(0, 1), b2 + hstepB, voffB);
            PG8_WAIT_V(6); PG8_BAR; PG8_MMA(1, 1, At, B1); PG8_BAR;
            PG8_LDB(B0, 1, 0); PG8_SCHED; PG8_LDA(At, 1, 0); PG8_STAGE(PG8_SA(0, 1), a2 + hstepA, voffA);
            PG8_WAIT_L(8); PG8_BAR; PG8_WAIT_L(0); PG8_MMA(0, 0, At, B0); PG8_BAR; PG8_SCHED;
            PG8_LDB(B1, 1, 1); PG8_STAGE(PG8_SB(1, 0), b3, voffB);
            PG8_BAR; PG8_WAIT_L(0); PG8_MMA(0, 1, At, B1); PG8_BAR;
            PG8_LDA(At, 1, 1); PG8_STAGE(PG8_SA(1, 0), a3, voffA);
            PG8_BAR; PG8_WAIT_L(0); PG8_MMA(1, 0, At, B0); PG8_BAR; PG8_SCHED;
            PG8_STAGE(PG8_SB(1, 1), b3 + hstepB, voffB);
            PG8_WAIT_V(6); PG8_BAR; PG8_MMA(1, 1, At, B1); PG8_BAR;
            }
        }
        if constexpr (ALIGN_EPI) { if (wr == 0) PG8_BAR; }
        if constexpr (!Epi::AFTER_DRAIN) { E(acc, cur, wr, wc, fr, fq); S.done(cur); }
        if (!has_next) break;
#pragma unroll
        for (int a = 0; a < 2; ++a)
#pragma unroll
            for (int b = 0; b < 2; ++b)
#pragma unroll
                for (int m = 0; m < 4; ++m)
#pragma unroll
                    for (int n = 0; n < 2; ++n) acc[a][b][m][n] = (f32x4){0.f, 0.f, 0.f, 0.f};
        cur = nxt; cA = nA; cB = nB; ++ui;
        if constexpr (ALIGN_EPI) { if (wr == 1) PG8_BAR; }
    }
    PG8_WAIT_V(0);
    if constexpr (!ALIGN_EPI) { if (wr == 0) PG8_BAR; }
    PG8_BAR;
    if constexpr (Epi::AFTER_DRAIN) { E.fused(acc, cur, wr, wc, fr, fq, lds, wid, lane); S.done(cur); }
#undef PG8_SA
#undef PG8_SB
#undef PG8_STAGE
#undef PG8_LDA
#undef PG8_LDB
#undef PG8_MMA
#undef PG8_WAIT_V
#undef PG8_WAIT_L
#undef PG8_BAR
#undef PG8_SCHED
}
}

#define GAS __attribute__((address_space(1)))
#define LAS __attribute__((address_space(3)))
typedef unsigned short bf16;
typedef unsigned v4u __attribute__((ext_vector_type(4)));
typedef float f32x4 __attribute__((ext_vector_type(4)));
typedef short bf16x8 __attribute__((ext_vector_type(8)));
typedef GAS unsigned gu32;
typedef GAS unsigned long long gu64;
#define RLX_AGENT __ATOMIC_RELAXED, __HIP_MEMORY_SCOPE_AGENT
#define LDS_WAIT() asm volatile("s_waitcnt lgkmcnt(0)" ::: "memory")
#define VM_WAIT() asm volatile("s_waitcnt vmcnt(0)" ::: "memory")
__device__ __forceinline__ unsigned long long rt() { return __builtin_amdgcn_s_memrealtime(); }
__device__ __forceinline__ unsigned f2bf(float f) { unsigned u = __builtin_bit_cast(unsigned, f); return (u + 0x7fffu + ((u >> 16) & 1u)) >> 16; }
__device__ __forceinline__ unsigned pk2(float lo, float hi) { return f2bf(lo) | (f2bf(hi) << 16); }

#define XB_TMO      128
#define XB_XCNT(j)  (256  + 64 * (j))
#define XB_XSUB(j)  (1280 + 64 * (j))
#define XB_XGEN(j)  (2304 + 64 * (j))
#define XB_TOP      3328
#define XB_TOPGEN   3392
#define XCD_BAR_WORDS 3456
#define XB_SPIN_CAP (1u << 18)

__device__ __forceinline__ unsigned xb_ld(unsigned* p)              { return __hip_atomic_load(p, __ATOMIC_RELAXED, __HIP_MEMORY_SCOPE_AGENT); }
__device__ __forceinline__ unsigned xb_add(unsigned* p, unsigned v) { return __hip_atomic_fetch_add(p, v, __ATOMIC_RELAXED, __HIP_MEMORY_SCOPE_AGENT); }
__device__ __forceinline__ unsigned xb_xcc_id() { return (unsigned)__builtin_amdgcn_s_getreg((3 << 11) | 20) & 0xFu; }
#define XB_SPIN(cond, bar) do { unsigned _sp = 0; while (cond) { __builtin_amdgcn_s_sleep(1); \
    if ((++_sp & 255u) == 0u) { if (xb_ld(&(bar)[XB_TMO])) break; if (_sp > XB_SPIN_CAP) { atomicAdd(&(bar)[XB_TMO], 1u); break; } } } } while (0)

struct XcdBarrier {
    unsigned* bar; unsigned x;
    volatile LAS unsigned* st;
};

__device__ __forceinline__ XcdBarrier xcd_barrier_post(unsigned* bar, volatile LAS unsigned* st) {
    XcdBarrier b; b.bar = bar; b.x = xb_xcc_id(); b.st = st;
    if (threadIdx.x == 0) (void)xb_add(&bar[XB_XCNT(b.x)], 1u);
    return b;
}
__device__ __forceinline__ void xcd_barrier_complete(unsigned* bar, unsigned x, unsigned& nloc, unsigned& nx) {
    const unsigned G = gridDim.x * gridDim.y * gridDim.z;
    unsigned sum, cnt, mine, sp = 0u;
    for (;;) {
        sum = 0u; cnt = 0u; mine = 0u;
#pragma unroll
        for (unsigned j = 0; j < 16; ++j) { const unsigned c = xb_ld(&bar[XB_XCNT(j)]); sum += c; cnt += (c > 0u) ? 1u : 0u; mine = (j == x) ? c : mine; }
        if (sum == G) break;
        __builtin_amdgcn_s_sleep(1);
        if ((++sp & 255u) == 0u) { if (xb_ld(&bar[XB_TMO])) break; if (sp > XB_SPIN_CAP) { atomicAdd(&bar[XB_TMO], 1u); break; } }
    }
    nloc = mine > 0u ? mine : 1u; nx = cnt > 0u ? cnt : 1u;
}

__device__ __forceinline__ void xcd_barrier(const XcdBarrier& b) {
    asm volatile("s_waitcnt vmcnt(0)" ::: "memory");
    __syncthreads();
    if (threadIdx.x == 0) {
        unsigned* bar = b.bar;
        __builtin_amdgcn_s_waitcnt(0);
        unsigned nloc = b.st[0], nx = b.st[1];
        if (nloc == 0u) { xcd_barrier_complete(bar, b.x, nloc, nx); b.st[0] = nloc; b.st[1] = nx; }
        const unsigned old = xb_add(&bar[XB_XSUB(b.x)], 1u);
        const unsigned gen = old / nloc;
        if (old + 1u == (gen + 1u) * nloc) {
            __builtin_amdgcn_fence(__ATOMIC_RELEASE, "agent");
            asm volatile("s_waitcnt vmcnt(0)" ::: "memory");
            const unsigned og = xb_add(&bar[XB_TOP], 1u);
            const unsigned tg = og / nx;
            if (og + 1u == (tg + 1u) * nx) xb_add(&bar[XB_TOPGEN], 1u);
            else XB_SPIN(xb_ld(&bar[XB_TOPGEN]) == tg, bar);
            __builtin_amdgcn_fence(__ATOMIC_ACQUIRE, "agent");
            xb_add(&bar[XB_XGEN(b.x)], 1u);
            asm volatile("s_waitcnt vmcnt(0)" ::: "memory");
        } else {
            XB_SPIN(xb_ld(&bar[XB_XGEN(b.x)]) == gen, bar);
            __builtin_amdgcn_fence(__ATOMIC_ACQUIRE, "agent");
            asm volatile("s_waitcnt vmcnt(0)" ::: "memory");
        }
    }
    __syncthreads();
}

constexpr int NWAVES = 8;
constexpr int BATCH = 32, SEQ = 2048, DM = 1024, DEPTH = 4, INW = 11264;
constexpr int MTOK = BATCH * SEQ;
constexpr int NGRP = 2, MG = MTOK / NGRP;
constexpr float EPS = 1e-6f;
constexpr size_t MiB = 1u << 20;
constexpr size_t WS_CTL = 0, CTL_ZERO_BYTES = 1 * MiB;
constexpr size_t WS_MOD = 1 * MiB;
constexpr size_t WS_WIN = 4 * MiB;
constexpr size_t WS_WPA = 92 * MiB;
constexpr size_t WS_WPR = 96 * MiB;
constexpr size_t WS_WOUT = 104 * MiB;
constexpr size_t WS_LSE = 112 * MiB;
constexpr size_t WS_H = 116 * MiB;
constexpr size_t WS_P = 180 * MiB;
constexpr size_t WS_END = WS_P + (size_t)MG * pg8::LDP * 2;
static_assert(WS_END <= 1024 * MiB, "workspace map");
constexpr int CW_BAR = 4096;
constexpr int RING_OFF = 0, RING_BYTES = 131072;
constexpr int LDSCTL_OFF = RING_BYTES, MISC_OFF = LDSCTL_OFF + 320;
constexpr int LDS_BYTES = 147456;

struct Args { const float* x; const float* c; const int* pos; const float* norm_w; const float* w_ada; const float* b_ada; const float* w_in; const float* gn_w;
              const float* w_pa; const float* w_pr; const float* w_out; const float* fnw; float* out; unsigned char* ws; int ph_lo, ph_hi, l_lo, l_hi, g_lo, g_hi; };
static_assert(sizeof(Args) == 14 * 8 + 6 * 4, "Args has no padding");

struct Frame {
    LAS unsigned char* lds;
    int tid, lane, wave, vcu, G, bx;
};
__device__ __forceinline__ Frame mkframe() {
    Frame F; extern __shared__ __attribute__((aligned(16))) unsigned char lds[];
    F.lds = (LAS unsigned char*)lds;
    int t = threadIdx.x; asm volatile("" : "+v"(t)); int bx = blockIdx.x, G = gridDim.x; asm volatile("" : "+s"(bx), "+s"(G));
    F.tid = t; F.lane = t & 63; F.wave = __builtin_amdgcn_readfirstlane(t >> 6); F.G = G; F.bx = bx;
    F.vcu = (G % 8 == 0) ? (bx % 8) * (G / 8) + bx / 8 : bx;
    return F;
}
typedef const __attribute__((address_space(4))) Args* KArgs;
__device__ __forceinline__ KArgs kargs() { KArgs p = (KArgs)__builtin_amdgcn_kernarg_segment_ptr(); asm volatile("" : "+s"(p)); return p; }

__device__ __forceinline__ float wave_sum(float v) {
#pragma unroll
    for (int o = 1; o < 64; o <<= 1) v += __shfl_xor(v, o);
    return v;
}
__device__ __forceinline__ float blo(unsigned w) { return __uint_as_float(w << 16); }
__device__ __forceinline__ float bhi(unsigned w) { return __uint_as_float(w & 0xffff0000u); }
__device__ __forceinline__ float silu_f(float x) { return x / (1.0f + __expf(-x)); }

__device__ __forceinline__ void p0_transpose_item(const float* W, int K, int N, bf16* WT, LAS float* scr, int item, int lane) {
    const int nblk = N / 32, kb = item / nblk, nb = item % nblk, k0 = 64 * kb, n0 = 32 * nb;
#pragma unroll 8
    for (int i = 0; i < 32; ++i) { const int kk = 2 * i + (lane >> 5); scr[kk * 33 + (lane & 31)] = W[(size_t)(k0 + kk) * N + n0 + (lane & 31)]; }
    LDS_WAIT(); asm volatile("" ::: "memory");
    const int c = lane & 7;
#pragma unroll
    for (int j = 0; j < 4; ++j) { const int n = (lane >> 3) + 8 * j; const LAS float* s = scr + (8 * c) * 33 + n;
        v4u o; o.x = pk2(s[0 * 33], s[1 * 33]); o.y = pk2(s[2 * 33], s[3 * 33]); o.z = pk2(s[4 * 33], s[5 * 33]); o.w = pk2(s[6 * 33], s[7 * 33]);
        *(GAS v4u*)(WT + (size_t)(n0 + n) * K + k0 + 8 * c) = o; }
    LDS_WAIT(); asm volatile("" ::: "memory");
}
__device__ __forceinline__ void p0_mod_item(Frame& F, const float* cin, const float* w_ada, const float* b_ada, float* MOD, int item) {
    const int l = item / 48, n0 = (item % 48) * 64;
    LAS float* cact = (LAS float*)(F.lds + RING_OFF);
    for (int i = F.tid; i < BATCH * DM; i += NWAVES * 64) cact[i] = silu_f(cin[i]);
    LDS_WAIT(); __syncthreads();
    float acc[BATCH];
#pragma unroll
    for (int b = 0; b < BATCH; ++b) acc[b] = 0.f;
    const float* wp = w_ada + ((size_t)l * DM + F.wave * 128) * 3072 + n0 + F.lane;
    for (int k4 = 0; k4 < 32; ++k4) {
        const float w0 = wp[(size_t)(4 * k4 + 0) * 3072], w1 = wp[(size_t)(4 * k4 + 1) * 3072], w2 = wp[(size_t)(4 * k4 + 2) * 3072], w3 = wp[(size_t)(4 * k4 + 3) * 3072];
#pragma unroll
        for (int b = 0; b < BATCH; ++b) { const f32x4 cv = *(const LAS f32x4*)(cact + b * DM + F.wave * 128 + 4 * k4);
            acc[b] += cv.x * w0 + cv.y * w1 + cv.z * w2 + cv.w * w3; }
    }
    __syncthreads();
    LAS float* part = (LAS float*)(F.lds + RING_OFF);
#pragma unroll
    for (int b = 0; b < BATCH; ++b) part[(F.wave * BATCH + b) * 64 + F.lane] = acc[b];
    LDS_WAIT(); __syncthreads();
    for (int o = F.tid; o < BATCH * 64; o += NWAVES * 64) { const int b = o >> 6, cn = o & 63; float s = 0.f;
#pragma unroll
        for (int w = 0; w < NWAVES; ++w) s += part[(w * BATCH + b) * 64 + cn];
        MOD[((size_t)l * BATCH + b) * 3072 + n0 + cn] = s + b_ada[l * 3072 + n0 + cn]; }
    LDS_WAIT(); __syncthreads();
}
__device__ __forceinline__ void p0_prologue(Frame& F, KArgs a, unsigned char* ws) {
    if (F.bx < DEPTH * 48) p0_mod_item(F, a->c, a->w_ada, a->b_ada, (float*)(ws + WS_MOD), F.bx);
    LAS float* scr = (LAS float*)(F.lds + RING_OFF + F.wave * 16384);
    const int gw = F.vcu * NWAVES + F.wave, NGW = F.G * NWAVES;
    constexpr int I_IN = (DM / 64) * (INW / 32), I_PA = (512 / 64) * (DM / 32), I_PR = (DM / 64) * (DM / 32), I_L = I_IN + I_PA + 2 * I_PR;
    const float* w_in = a->w_in; const float* w_pa = a->w_pa; const float* w_pr = a->w_pr; const float* w_out = a->w_out;
    bf16* Win = (bf16*)(ws + WS_WIN); bf16* Wpa = (bf16*)(ws + WS_WPA); bf16* Wpr = (bf16*)(ws + WS_WPR); bf16* Wout = (bf16*)(ws + WS_WOUT);
    for (int it = gw; it < DEPTH * I_L; it += NGW) {
        const int l = it / I_L; int r = it % I_L;
        if (r < I_IN) { p0_transpose_item(w_in + (size_t)l * DM * INW, DM, INW, Win + (size_t)l * INW * DM, scr, r, F.lane); continue; } r -= I_IN;
        if (r < I_PA) { p0_transpose_item(w_pa + (size_t)l * 512 * DM, 512, DM, Wpa + (size_t)l * DM * 512, scr, r, F.lane); continue; } r -= I_PA;
        if (r < I_PR) { p0_transpose_item(w_pr + (size_t)l * DM * DM, DM, DM, Wpr + (size_t)l * DM * DM, scr, r, F.lane); continue; } r -= I_PR;
        p0_transpose_item(w_out + (size_t)l * DM * DM, DM, DM, Wout + (size_t)l * DM * DM, scr, r, F.lane);
    }
}
__device__ __forceinline__ void norm_phase(Frame& F, const float* xs, const float* nw, const float* MODl, bf16* H, int tok0) {
    const int gw = F.vcu * NWAVES + F.wave, NGW = F.G * NWAVES;
    for (int m = gw; m < MG; m += NGW) {
        const int tok = tok0 + m, b = tok >> 11;
        const float* mod = MODl + (size_t)b * 3072;
        const GAS f32x4* xr = (const GAS f32x4*)(xs + (size_t)tok * DM) + F.lane;
        f32x4 v[4]; float s = 0.f;
#pragma unroll
        for (int j = 0; j < 4; ++j) { v[j] = xr[64 * j]; s += (v[j].x * v[j].x + v[j].y * v[j].y) + (v[j].z * v[j].z + v[j].w * v[j].w); }
        const float rstd = 1.0f / sqrtf(wave_sum(s) * (1.f / DM) + EPS);
        GAS unsigned long long* o8 = (GAS unsigned long long*)(H + (size_t)m * DM) + F.lane;
#pragma unroll
        for (int j = 0; j < 4; ++j) { const int c = 4 * F.lane + 256 * j;
            const f32x4 w = *(const f32x4*)(nw + c), sh = *(const f32x4*)(mod + c), sc = *(const f32x4*)(mod + 1024 + c);
            const f32x4 y = v[j] * rstd * w * (sc + 1.0f) + sh;
            o8[64 * j] = (unsigned long long)pk2(y.x, y.y) | ((unsigned long long)pk2(y.z, y.w) << 32); }
    }
}
__device__ __forceinline__ void final_norm_phase(Frame& F, float* out, const float* fnw) {
    const int gw = F.vcu * NWAVES + F.wave, NGW = F.G * NWAVES;
    for (int m = gw; m < MTOK; m += NGW) {
        GAS f32x4* xr = (GAS f32x4*)(out + (size_t)m * DM) + F.lane;
        f32x4 v[4]; float s = 0.f;
#pragma unroll
        for (int j = 0; j < 4; ++j) { v[j] = xr[64 * j]; s += (v[j].x * v[j].x + v[j].y * v[j].y) + (v[j].z * v[j].z + v[j].w * v[j].w); }
        const float rstd = 1.0f / sqrtf(wave_sum(s) * (1.f / DM) + EPS);
#pragma unroll
        for (int j = 0; j < 4; ++j) { const f32x4 w = *(const f32x4*)(fnw + 4 * F.lane + 256 * j); xr[64 * j] = v[j] * rstd * w; }
    }
}
__device__ __forceinline__ void attn_naive_phase(Frame& F, bf16* P, float* LSE) {
    const int gtid = F.vcu * (NWAVES * 64) + F.tid, NT = F.G * NWAVES * 64;
    for (int it2 = gtid; it2 < 2 * 12 * MG; it2 += NT) {
        const int item = it2 >> 1, half = it2 & 1;
        const int hg = item / MG, n = item % MG, gi = hg >> 2, dsh = 2 * gi, Lsub = SEQ >> dsh;
        const int b = n >> 11, rem = n & 2047, r = rem >> (11 - dsh), m = rem & (Lsub - 1);
        const int row = b * SEQ + (m << dsh) + r;
        bf16* qp = P + (size_t)row * pg8::LDP + pg8::C_QA + hg * 128 + half * 64;
        v4u q[8];
#pragma unroll
        for (int i = 0; i < 8; ++i) q[i] = *(const GAS v4u*)(qp + 8 * i);
        float o[64];
#pragma unroll
        for (int i = 0; i < 64; ++i) o[i] = 0.f;
        float mrun = -1e30f, lsum = 0.f;
        const int mlo = m > 128 ? m - 128 : 0;
        for (int mk = mlo; mk <= m; ++mk) {
            const bf16* kp = P + (size_t)(b * SEQ + (mk << dsh) + r) * pg8::LDP + pg8::C_KA + hg * 128 + half * 64;
            float d0 = 0.f, d1 = 0.f;
#pragma unroll
            for (int i = 0; i < 8; ++i) { const v4u kv = *(const GAS v4u*)(kp + 8 * i);
                d0 += blo(q[i].x) * blo(kv.x) + blo(q[i].y) * blo(kv.y) + blo(q[i].z) * blo(kv.z) + blo(q[i].w) * blo(kv.w);
                d1 += bhi(q[i].x) * bhi(kv.x) + bhi(q[i].y) * bhi(kv.y) + bhi(q[i].z) * bhi(kv.z) + bhi(q[i].w) * bhi(kv.w); }
            float dt = d0 + d1; dt += __shfl_xor(dt, 1);
            const float sc = dt * 0.08838834764831845f;
            const float mn = fmaxf(mrun, sc), al = __expf(mrun - mn), p = __expf(sc - mn);
            lsum = lsum * al + p; mrun = mn;
            const bf16* vp = kp + (pg8::C_VA - pg8::C_KA);
#pragma unroll
            for (int i = 0; i < 8; ++i) { const v4u vv = *(const GAS v4u*)(vp + 8 * i);
                o[8 * i + 0] = o[8 * i + 0] * al + p * blo(vv.x); o[8 * i + 1] = o[8 * i + 1] * al + p * bhi(vv.x);
                o[8 * i + 2] = o[8 * i + 2] * al + p * blo(vv.y); o[8 * i + 3] = o[8 * i + 3] * al + p * bhi(vv.y);
                o[8 * i + 4] = o[8 * i + 4] * al + p * blo(vv.z); o[8 * i + 5] = o[8 * i + 5] * al + p * bhi(vv.z);
                o[8 * i + 6] = o[8 * i + 6] * al + p * blo(vv.w); o[8 * i + 7] = o[8 * i + 7] * al + p * bhi(vv.w); }
        }
        const float inv = 1.0f / lsum;
#pragma unroll
        for (int i = 0; i < 8; ++i) { v4u w; w.x = pk2(o[8 * i] * inv, o[8 * i + 1] * inv); w.y = pk2(o[8 * i + 2] * inv, o[8 * i + 3] * inv);
            w.z = pk2(o[8 * i + 4] * inv, o[8 * i + 5] * inv); w.w = pk2(o[8 * i + 6] * inv, o[8 * i + 7] * inv); *(GAS v4u*)(qp + 8 * i) = w; }
        if (half == 0) LSE[(size_t)row * 12 + hg] = mrun + __logf(lsum);
    }
}
__device__ __forceinline__ void ret_naive_phase(Frame& F, const bf16* P, bf16* H) {
    const int gtid = F.vcu * (NWAVES * 64) + F.tid, NT = F.G * NWAVES * 64;
    for (int it4 = gtid; it4 < 4 * 4 * MG; it4 += NT) {
        const int it0 = __builtin_amdgcn_readfirstlane(it4) >> 2;
        const int h = it0 / MG, n0 = it0 % MG, b = n0 >> 11, s0 = n0 & 2047, s = s0 + (F.lane >> 2), qd = F.lane & 3;
        const int row = b * SEQ + s;
        const float lg = __builtin_log2f(1.0f - __builtin_amdgcn_exp2f(-5.0f - (float)h));
        const bf16* qp = P + (size_t)row * pg8::LDP + pg8::C_QR + h * 256 + qd * 64;
        v4u q[8];
#pragma unroll
        for (int i = 0; i < 8; ++i) q[i] = *(const GAS v4u*)(qp + 8 * i);
        float o[64];
#pragma unroll
        for (int i = 0; i < 64; ++i) o[i] = 0.f;
        const int ci = s >> 7;
        for (int j = 0; j <= s0 + 15; ++j) {
            const bf16* kp = P + (size_t)(b * SEQ + j) * pg8::LDP + pg8::C_KR + h * 256 + qd * 64;
            float d0 = 0.f, d1 = 0.f;
#pragma unroll
            for (int i = 0; i < 8; ++i) { const v4u kv = *(const GAS v4u*)(kp + 8 * i);
                d0 += blo(q[i].x) * blo(kv.x) + blo(q[i].y) * blo(kv.y) + blo(q[i].z) * blo(kv.z) + blo(q[i].w) * blo(kv.w);
                d1 += bhi(q[i].x) * bhi(kv.x) + bhi(q[i].y) * bhi(kv.y) + bhi(q[i].z) * bhi(kv.z) + bhi(q[i].w) * bhi(kv.w); }
            float dt = d0 + d1; dt += __shfl_xor(dt, 1); dt += __shfl_xor(dt, 2);
            float w = dt * __builtin_amdgcn_exp2f((float)(128 * (ci - (j >> 7))) * lg);
            if (j > s) w = 0.f;
            const bf16* vp = kp + (pg8::C_VR - pg8::C_KR);
#pragma unroll
            for (int i = 0; i < 8; ++i) { const v4u vv = *(const GAS v4u*)(vp + 8 * i);
                o[8 * i + 0] += w * blo(vv.x); o[8 * i + 1] += w * bhi(vv.x); o[8 * i + 2] += w * blo(vv.y); o[8 * i + 3] += w * bhi(vv.y);
                o[8 * i + 4] += w * blo(vv.z); o[8 * i + 5] += w * bhi(vv.z); o[8 * i + 6] += w * blo(vv.w); o[8 * i + 7] += w * bhi(vv.w); }
        }
        bf16* op = H + (size_t)row * DM + h * 256 + qd * 64;
#pragma unroll
        for (int i = 0; i < 8; ++i) { v4u w; w.x = pk2(o[8 * i], o[8 * i + 1]); w.y = pk2(o[8 * i + 2], o[8 * i + 3]); w.z = pk2(o[8 * i + 4], o[8 * i + 5]); w.w = pk2(o[8 * i + 6], o[8 * i + 7]);
            *(GAS v4u*)(op + 8 * i) = w; }
    }
}
__device__ __forceinline__ void combine_phase(Frame& F, bf16* P, const bf16* H, const float* LSE, const float* gnw) {
    const int gw = F.vcu * NWAVES + F.wave, NGW = F.G * NWAVES, L = F.lane;
    for (int m = gw; m < MG; m += NGW) {
        bf16* pr = P + (size_t)m * pg8::LDP;
        {
            const int j = L >> 4, c0 = 8 * L, d0 = c0 & 127;
            const float l0 = LSE[(size_t)m * 12 + j], l1 = LSE[(size_t)m * 12 + 4 + j], l2 = LSE[(size_t)m * 12 + 8 + j];
            const float mx = fmaxf(l0, fmaxf(l1, l2));
            float e0 = __expf(l0 - mx), e1 = __expf(l1 - mx), e2 = __expf(l2 - mx);
            const float inv = 1.0f / (e0 + e1 + e2); e0 *= inv; e1 *= inv; e2 *= inv;
            const v4u a0 = *(const GAS v4u*)(pr + pg8::C_QA + (0 + j) * 128 + d0), a1 = *(const GAS v4u*)(pr + pg8::C_QA + (4 + j) * 128 + d0), a2 = *(const GAS v4u*)(pr + pg8::C_QA + (8 + j) * 128 + d0);
            const v4u z = *(const GAS v4u*)(pr + pg8::C_ZA + c0);
            v4u w;
#define CMB2(f) pk2((e0 * blo(a0.f) + e1 * blo(a1.f) + e2 * blo(a2.f)) * blo(z.f), (e0 * bhi(a0.f) + e1 * bhi(a1.f) + e2 * bhi(a2.f)) * bhi(z.f))
            w.x = CMB2(x); w.y = CMB2(y); w.z = CMB2(z); w.w = CMB2(w);
#undef CMB2
            *(GAS v4u*)(pr + pg8::C_ZA + c0) = w;
        }
        {
            const int c0 = 16 * L;
            const v4u u0 = *(const GAS v4u*)(H + (size_t)m * DM + c0), u1 = *(const GAS v4u*)(H + (size_t)m * DM + c0 + 8);
            float v[16] = {blo(u0.x), bhi(u0.x), blo(u0.y), bhi(u0.y), blo(u0.z), bhi(u0.z), blo(u0.w), bhi(u0.w), blo(u1.x), bhi(u1.x), blo(u1.y), bhi(u1.y), blo(u1.z), bhi(u1.z), blo(u1.w), bhi(u1.w)};
            float s = 0.f;
#pragma unroll
            for (int i = 0; i < 16; ++i) s += v[i];
            s += __shfl_xor(s, 1); s += __shfl_xor(s, 2); s += __shfl_xor(s, 4); s += __shfl_xor(s, 8);
            const float mu = s * (1.0f / 256.0f); float q = 0.f;
#pragma unroll
            for (int i = 0; i < 16; ++i) { v[i] -= mu; q += v[i] * v[i]; }
            q += __shfl_xor(q, 1); q += __shfl_xor(q, 2); q += __shfl_xor(q, 4); q += __shfl_xor(q, 8);
            const float rstd = 1.0f / sqrtf(q * (1.0f / 256.0f) + EPS);
            const v4u z0 = *(const GAS v4u*)(pr + pg8::C_ZR + c0), z1 = *(const GAS v4u*)(pr + pg8::C_ZR + c0 + 8);
            const float zz[16] = {blo(z0.x), bhi(z0.x), blo(z0.y), bhi(z0.y), blo(z0.z), bhi(z0.z), blo(z0.w), bhi(z0.w), blo(z1.x), bhi(z1.x), blo(z1.y), bhi(z1.y), blo(z1.z), bhi(z1.z), blo(z1.w), bhi(z1.w)};
            float y[16];
#pragma unroll
            for (int i = 0; i < 4; ++i) { const f32x4 g = *(const f32x4*)(gnw + c0 + 4 * i);
                y[4 * i] = v[4 * i] * rstd * g.x * zz[4 * i]; y[4 * i + 1] = v[4 * i + 1] * rstd * g.y * zz[4 * i + 1]; y[4 * i + 2] = v[4 * i + 2] * rstd * g.z * zz[4 * i + 2]; y[4 * i + 3] = v[4 * i + 3] * rstd * g.w * zz[4 * i + 3]; }
            v4u w0, w1; w0.x = pk2(y[0], y[1]); w0.y = pk2(y[2], y[3]); w0.z = pk2(y[4], y[5]); w0.w = pk2(y[6], y[7]); w1.x = pk2(y[8], y[9]); w1.y = pk2(y[10], y[11]); w1.z = pk2(y[12], y[13]); w1.w = pk2(y[14], y[15]);
            *(GAS v4u*)(pr + pg8::C_ZR + c0) = w0; *(GAS v4u*)(pr + pg8::C_ZR + c0 + 8) = w1;
        }
    }
}

__global__ void __launch_bounds__(NWAVES * 64, 2) fwd_kernel(Args a_unused) {
    extern __shared__ __attribute__((aligned(16))) unsigned char lds[];
    volatile LAS unsigned* MISC = (volatile LAS unsigned*)((LAS unsigned char*)lds + MISC_OFF);
    for (int u = threadIdx.x; u < (LDS_BYTES - LDSCTL_OFF) / 4; u += NWAVES * 64) ((LAS unsigned*)((LAS unsigned char*)lds + LDSCTL_OFF))[u] = 0u;
    __syncthreads();
    KArgs a0 = kargs();
    const int ph_lo = a0->ph_lo, ph_hi = a0->ph_hi;
    const bool fused = (ph_hi - ph_lo) > 1;
    XcdBarrier bar; bar.bar = (unsigned*)(a0->ws + WS_CTL) + CW_BAR; bar.x = 0; bar.st = nullptr;
    if (fused) bar = xcd_barrier_post((unsigned*)(a0->ws + WS_CTL) + CW_BAR, MISC + 8);
#ifndef PH_MASK
#define PH_MASK 0x1ff
#endif
#define IN(k) (((PH_MASK >> (k)) & 1) && ph_lo <= (k) && (k) < ph_hi)
#define SEAM() do { if (fused) xcd_barrier(bar); } while (0)

    if (IN(0)) { KArgs a = kargs(); Frame F = mkframe(); p0_prologue(F, a, a->ws); SEAM(); }

    const int l_lo = a0->l_lo, l_hi = a0->l_hi, g_lo = a0->g_lo, g_hi = a0->g_hi;
    for (int l = l_lo; l < l_hi; ++l)
        for (int g = g_lo; g < g_hi; ++g) {
            const int tok0 = g * MG;
            if (IN(1)) { KArgs a = kargs(); unsigned char* ws = a->ws; Frame F = mkframe();
                norm_phase(F, (l == 0) ? a->x : a->out, a->norm_w + l * DM, (const float*)(ws + WS_MOD) + (size_t)l * BATCH * 3072, (bf16*)(ws + WS_H), tok0); SEAM(); }
            if (IN(2)) { KArgs a = kargs(); unsigned char* ws = a->ws; Frame F = mkframe();
                pg8::Gemm gm{(const bf16*)(ws + WS_H), (const bf16*)(ws + WS_WIN) + (size_t)l * INW * DM}; pg8::StaticOrder S; S.init(MG, INW, F.G, F.bx);
                pg8::EpiProj E{(bf16*)(ws + WS_P), a->pos + tok0, tok0};
                pg8::gemm_phase<pg8::EpiProj, pg8::StaticOrder, true, true, DM, DM, DM>(F.lds + RING_OFF, gm, S, E);
                SEAM();
            }
            if (IN(3)) { KArgs a = kargs(); unsigned char* ws = a->ws; Frame F = mkframe(); attn_naive_phase(F, (bf16*)(ws + WS_P), (float*)(ws + WS_LSE)); SEAM(); }
            if (IN(4)) { KArgs a = kargs(); unsigned char* ws = a->ws; Frame F = mkframe(); ret_naive_phase(F, (const bf16*)(ws + WS_P), (bf16*)(ws + WS_H)); SEAM(); }
            if (IN(5)) { KArgs a = kargs(); unsigned char* ws = a->ws; Frame F = mkframe(); combine_phase(F, (bf16*)(ws + WS_P), (const bf16*)(ws + WS_H), (const float*)(ws + WS_LSE), a->gn_w + l * DM); SEAM(); }
            if (IN(6)) {
                { KArgs a = kargs(); unsigned char* ws = a->ws; Frame F = mkframe();
                  pg8::Gemm gm{(const bf16*)(ws + WS_P) + pg8::C_ZA, (const bf16*)(ws + WS_WPA) + (size_t)l * DM * 512}; pg8::StaticOrder S; S.init(MG, DM, F.G, F.bx);
                  pg8::EpiGate<0> E{(bf16*)(ws + WS_P)};
                  pg8::gemm_phase<pg8::EpiGate<0>, pg8::StaticOrder, true, true, 512, pg8::LDP, 512>(F.lds + RING_OFF, gm, S, E); }
                { KArgs a = kargs(); unsigned char* ws = a->ws; Frame F = mkframe();
                  pg8::Gemm gm{(const bf16*)(ws + WS_P) + pg8::C_ZR, (const bf16*)(ws + WS_WPR) + (size_t)l * DM * DM}; pg8::StaticOrder S; S.init(MG, DM, F.G, F.bx);
                  pg8::EpiGate<1> E{(bf16*)(ws + WS_P)};
                  pg8::gemm_phase<pg8::EpiGate<1>, pg8::StaticOrder, true, true, DM, pg8::LDP, DM>(F.lds + RING_OFF, gm, S, E); }
                SEAM();
            }
            if (IN(7)) { KArgs a = kargs(); unsigned char* ws = a->ws; Frame F = mkframe();
                pg8::Gemm gm{(const bf16*)(ws + WS_P) + pg8::C_GA, (const bf16*)(ws + WS_WOUT) + (size_t)l * DM * DM}; pg8::StaticOrder S; S.init(MG, DM, F.G, F.bx);
                pg8::EpiOut E{(l == 0) ? a->x : a->out, a->out, (const float*)(ws + WS_MOD) + (size_t)l * BATCH * 3072 + 2048, tok0};
                pg8::gemm_phase<pg8::EpiOut, pg8::StaticOrder, true, true, DM, pg8::LDP, DM>(F.lds + RING_OFF, gm, S, E);
                SEAM();
            }
        }
    if (IN(8)) { KArgs a = kargs(); Frame F = mkframe(); final_norm_phase(F, a->out, a->fnw); }
#undef IN
#undef SEAM
}

extern "C" void kernel_launch(void* const* d_in, const int* in_sizes, int n_in, void* d_out, int out_size, void* d_ws, size_t ws_size, hipStream_t stream) {
    static int grid = 0;
    if (grid == 0) {
        if (n_in != 12 || in_sizes[0] != MTOK * DM || out_size != MTOK * DM || ws_size < WS_END) { fprintf(stderr, "kernel_launch: unexpected shapes / workspace (n_in %d, ws %zu, need %zu)\n", n_in, ws_size, (size_t)WS_END); grid = -1; return; }
        int dev = 0, cus = 0, per_cu = 0;
        if (hipGetDevice(&dev) != hipSuccess || hipDeviceGetAttribute(&cus, hipDeviceAttributeMultiprocessorCount, dev) != hipSuccess) { grid = -1; return; }
        if (hipFuncSetAttribute((const void*)fwd_kernel, hipFuncAttributeMaxDynamicSharedMemorySize, LDS_BYTES) != hipSuccess) { fprintf(stderr, "kernel_launch: hipFuncSetAttribute failed\n"); grid = -1; return; }
        if (hipOccupancyMaxActiveBlocksPerMultiprocessor(&per_cu, (const void*)fwd_kernel, NWAVES * 64, LDS_BYTES) != hipSuccess || per_cu < 1) { fprintf(stderr, "kernel_launch: occupancy query says %d\n", per_cu); }
        (void)hipGetLastError();
        grid = cus;
    }
    if (grid < 0) return;
    (void)hipMemsetAsync((char*)d_ws + WS_CTL, 0, CTL_ZERO_BYTES, stream);
    Args a{};
    a.x = (const float*)d_in[0]; a.c = (const float*)d_in[1]; a.pos = (const int*)d_in[2]; a.norm_w = (const float*)d_in[3]; a.w_ada = (const float*)d_in[4]; a.b_ada = (const float*)d_in[5];
    a.w_in = (const float*)d_in[6]; a.gn_w = (const float*)d_in[7]; a.w_pa = (const float*)d_in[8]; a.w_pr = (const float*)d_in[9]; a.w_out = (const float*)d_in[10]; a.fnw = (const float*)d_in[11];
    a.out = (float*)d_out; a.ws = (unsigned char*)d_ws;
#if MK_FUSED
    a.ph_lo = 0; a.ph_hi = 9; a.l_lo = 0; a.l_hi = DEPTH; a.g_lo = 0; a.g_hi = NGRP;
    hipLaunchKernelGGL(fwd_kernel, dim3(grid), dim3(NWAVES * 64), LDS_BYTES, stream, a);
#else
    auto launch = [&](int ph, int l, int g) { a.ph_lo = ph; a.ph_hi = ph + 1; a.l_lo = l; a.l_hi = l + 1; a.g_lo = g; a.g_hi = g + 1;
        hipLaunchKernelGGL(fwd_kernel, dim3(grid), dim3(NWAVES * 64), LDS_BYTES, stream, a); };
    a.ph_lo = 0; a.ph_hi = 1; a.l_lo = 0; a.l_hi = 0; a.g_lo = 0; a.g_hi = 0;
    hipLaunchKernelGGL(fwd_kernel, dim3(grid), dim3(NWAVES * 64), LDS_BYTES, stream, a);
    for (int l = 0; l < DEPTH; ++l) for (int g = 0; g < NGRP; ++g) for (int ph = 1; ph <= 7; ++ph) launch(ph, l, g);
    a.ph_lo = 8; a.ph_hi = 9; a.l_lo = 0; a.l_hi = 0; a.g_lo = 0; a.g_hi = 0;
    hipLaunchKernelGGL(fwd_kernel, dim3(grid), dim3(NWAVES * 64), LDS_BYTES, stream, a);
#endif
    const hipError_t le = hipPeekAtLastError();
    if (le != hipSuccess) fprintf(stderr, "kernel_launch: launch failed: %s\n", hipGetErrorName(le));
}
```

```cpp
#include <hip/hip_runtime.h>
#include <cstdio>
#include <cstdint>

#ifndef ATT_NAIVE
#define ATT_NAIVE 0
#endif
#ifndef RET_NAIVE
#define RET_NAIVE 0
#endif
#ifndef DUP_RET
#define DUP_RET 0
#endif
#ifndef DUP_ATT
#define DUP_ATT 0
#endif
#ifndef DUP_G1
#define DUP_G1 0
#endif
#ifndef DUP_TG
#define DUP_TG 0
#endif
#ifndef PROBE_SEL
#define PROBE_SEL -1
#endif
#ifndef TAIL_FUSED
#define TAIL_FUSED 1
#endif
#ifndef MK_FUSED
#define MK_FUSED 1
#endif

namespace pg8 {
#define PG8_LAS __attribute__((address_space(3)))
typedef unsigned short bf16_t;
typedef short bf16x8 __attribute__((ext_vector_type(8)));
typedef float f32x4 __attribute__((ext_vector_type(4)));
typedef unsigned u32x4 __attribute__((ext_vector_type(4)));
constexpr int BM = 256, BK = 64, HALF = 128, HTB = HALF * BK * 2  , STAGE_BYTES = 8 * HTB, NXCD = 8, WGM = 8;

__host__ __device__ __forceinline__ int lds_byte(int r, int c) { const int st = (r >> 4) * 2 + (c >> 5), rr = r & 15, cc = c & 31, ob = rr * 64 + cc * 2; return st * 1024 + (ob ^ (((ob >> 9) & 1) << 5)); }
__host__ __device__ __forceinline__ void stage_rc(int b, int& R, int& C) { const int st = b / 1024, sb = b % 1024, swz = sb ^ (((sb >> 9) & 1) << 5); R = (st >> 1) * 16 + swz / 64; C = (st & 1) * 32 + (swz % 64) / 2; }
__host__ __device__ __forceinline__ int perm32(int rho) { const int n = rho >> 4, i = rho & 15; return 8 * (i >> 2) + 4 * n + (i & 3); }

struct Unit { int pm, pn; };
struct Gemm { const bf16_t* A; const bf16_t* Bt; };

struct StaticOrder {
    int nM, nN, nwg, G, c;
    __host__ __device__ void init(int M, int N, int G_, int c_) { nM = M / BM; nN = N / BM; nwg = nM * nN; G = G_; c = c_; }
    __host__ __device__ bool next(int i, Unit& u) const {
        const long L = (long)i * G + c; if (L >= nwg) return false;
        int wgid = (int)L; { const int q = nwg / NXCD, r = nwg % NXCD, xcd = wgid % NXCD, off = wgid / NXCD; wgid = (xcd < r ? xcd * (q + 1) : r * (q + 1) + (xcd - r) * q) + off; }
        const int nig = WGM * nN, gid = wgid / nig, fm = gid * WGM, gsz = (nM - fm) < WGM ? (nM - fm) : WGM;
        u.pm = fm + ((wgid % nig) % gsz); u.pn = (wgid % nig) / gsz; return true;
    }
    __device__ __forceinline__ void a_ready(const Unit&) const {}
    __device__ __forceinline__ void done(const Unit&) const {}
};

__device__ __forceinline__ unsigned cvt_pk_bf16(float lo, float hi) { unsigned r; asm volatile("v_cvt_pk_bf16_f32 %0, %1, %2" : "=v"(r) : "v"(lo), "v"(hi)); return r; }
__device__ __forceinline__ float bf_lo(unsigned w) { return __uint_as_float(w << 16); }
__device__ __forceinline__ float bf_hi(unsigned w) { return __uint_as_float(w & 0xffff0000u); }
__device__ __forceinline__ float sigmoidf_(float x) { return __builtin_amdgcn_rcpf(1.0f + __builtin_amdgcn_exp2f(-1.4426950408889634f * x)); }

constexpr int LDP = 11264;
constexpr int C_QA = 0, C_KA = 1536, C_VA = 3072, C_ZA = 4608, C_QR = 5120, C_KR = 6144, C_VR = 7168, C_ZR = 8192, C_GA = 9216, C_GR = 10240;

struct EpiProj {
    static constexpr bool PERM = true, AFTER_DRAIN = false;
    bf16_t* P; const int* pos; int tok0;
    __device__ __forceinline__ void operator()(const f32x4 (&acc)[2][2][4][2], const Unit& u, int wr, int wc, int fr, int fq) const {
        const int pn = u.pn;
        const int row0 = u.pm * BM + wr * 64 + fr, col0 = pn * BM + wc * 32 + 8 * fq;
        const int mode = (pn >= 20 && pn < 24) ? 3 : (pn >= 24 && pn < 28) ? 4 : ((pn == 18) || (pn == 19) || (pn >= 32 && pn < 36)) ? 1 : (pn >= 36) ? 2 : 0;
        if (mode < 3) {
#pragma unroll
            for (int ai = 0; ai < 2; ++ai)
#pragma unroll
                for (int m = 0; m < 4; ++m) { bf16_t* rowp = P + (size_t)(row0 + ai * HALF + m * 16) * LDP + col0;
#pragma unroll
                    for (int bj = 0; bj < 2; ++bj) { f32x4 v0 = acc[ai][bj][m][0], v1 = acc[ai][bj][m][1];
                        if (mode == 1) {
#pragma unroll
                            for (int j = 0; j < 4; ++j) { v0[j] = v0[j] * sigmoidf_(v0[j]); v1[j] = v1[j] * sigmoidf_(v1[j]); } }
                        if (mode == 2) {
#pragma unroll
                            for (int j = 0; j < 4; ++j) { v0[j] = sigmoidf_(v0[j]); v1[j] = sigmoidf_(v1[j]); } }
                        u32x4 w; w.x = cvt_pk_bf16(v0[0], v0[1]); w.y = cvt_pk_bf16(v0[2], v0[3]); w.z = cvt_pk_bf16(v1[0], v1[1]); w.w = cvt_pk_bf16(v1[2], v1[3]);
                        *(u32x4*)(rowp + bj * HALF) = w; } }
        } else {
            const int h = pn & 3;
            const float lg = __builtin_log2f(1.0f - __builtin_amdgcn_exp2f(-5.0f - (float)h));
            float irev[2][4];
#pragma unroll
            for (int n = 0; n < 2; ++n)
#pragma unroll
                for (int j = 0; j < 4; ++j) { const int i = wc * 32 + 8 * fq + 4 * n + j;
                    irev[n][j] = __builtin_amdgcn_exp2f(-(float)i * (13.287712379549449f / 128.0f)) * 0.15915494309189535f; }
            int pv[2][4];
#pragma unroll
            for (int ai = 0; ai < 2; ++ai)
#pragma unroll
                for (int m = 0; m < 4; ++m) pv[ai][m] = pos[row0 + ai * HALF + m * 16];
#pragma unroll
            for (int ai = 0; ai < 2; ++ai)
#pragma unroll
                for (int m = 0; m < 4; ++m) { const int row = row0 + ai * HALF + m * 16; bf16_t* rowp = P + (size_t)row * LDP + col0;
                    const float p = (float)pv[ai][m]; const int ic = (tok0 + row) & 127;
                    const float dec = (mode == 3) ? __builtin_amdgcn_exp2f((float)(ic - 127) * lg) : __builtin_amdgcn_exp2f((float)(127 - ic) * lg) * 0.0625f;
                    f32x4 o1[2], o2[2];
#pragma unroll
                    for (int n = 0; n < 2; ++n)
#pragma unroll
                        for (int j = 0; j < 4; ++j) { const float rv = __builtin_amdgcn_fractf(p * irev[n][j]);
                            const float sn = __builtin_amdgcn_sinf(rv), cs = __builtin_amdgcn_cosf(rv);
                            const float t1 = acc[ai][0][m][n][j], t2 = acc[ai][1][m][n][j];
                            o1[n][j] = (t1 * cs - t2 * sn) * dec; o2[n][j] = (t2 * cs + t1 * sn) * dec; }
                    u32x4 w; w.x = cvt_pk_bf16(o1[0][0], o1[0][1]); w.y = cvt_pk_bf16(o1[0][2], o1[0][3]); w.z = cvt_pk_bf16(o1[1][0], o1[1][1]); w.w = cvt_pk_bf16(o1[1][2], o1[1][3]);
                    *(u32x4*)(rowp) = w;
                    w.x = cvt_pk_bf16(o2[0][0], o2[0][1]); w.y = cvt_pk_bf16(o2[0][2], o2[0][3]); w.z = cvt_pk_bf16(o2[1][0], o2[1][1]); w.w = cvt_pk_bf16(o2[1][2], o2[1][3]);
                    *(u32x4*)(rowp + HALF) = w;
                    asm volatile("" ::: "memory"); __builtin_amdgcn_sched_barrier(0); }
        }
    }
};
template <int STEP> struct EpiGate {
    static constexpr bool PERM = true, AFTER_DRAIN = false;
    bf16_t* P;
    __device__ __forceinline__ void operator()(const f32x4 (&acc)[2][2][4][2], const Unit& u, int wr, int wc, int fr, int fq) const {
        const int row0 = u.pm * BM + wr * 64 + fr, col0 = u.pn * BM + wc * 32 + 8 * fq;
#pragma unroll
        for (int ai = 0; ai < 2; ++ai)
#pragma unroll
            for (int m = 0; m < 4; ++m) { bf16_t* rowp = P + (size_t)(row0 + ai * HALF + m * 16) * LDP + col0;
#pragma unroll
                for (int bj = 0; bj < 2; ++bj) { const f32x4 a0 = acc[ai][bj][m][0], a1 = acc[ai][bj][m][1];
                    const u32x4 g = *(const u32x4*)(rowp + C_GA + bj * HALF);
                    f32x4 v0, v1;
                    if (STEP == 0) { v0 = (f32x4){bf_lo(g.x) * a0[0], bf_hi(g.x) * a0[1], bf_lo(g.y) * a0[2], bf_hi(g.y) * a0[3]};
                                     v1 = (f32x4){bf_lo(g.z) * a1[0], bf_hi(g.z) * a1[1], bf_lo(g.w) * a1[2], bf_hi(g.w) * a1[3]}; }
                    else { const u32x4 r = *(const u32x4*)(rowp + C_GR + bj * HALF);
                        v0 = (f32x4){bf_lo(g.x) + bf_lo(r.x) * a0[0], bf_hi(g.x) + bf_hi(r.x) * a0[1], bf_lo(g.y) + bf_lo(r.y) * a0[2], bf_hi(g.y) + bf_hi(r.y) * a0[3]};
                        v1 = (f32x4){bf_lo(g.z) + bf_lo(r.z) * a1[0], bf_hi(g.z) + bf_hi(r.z) * a1[1], bf_lo(g.w) + bf_lo(r.w) * a1[2], bf_hi(g.w) + bf_hi(r.w) * a1[3]}; }
                    u32x4 w; w.x = cvt_pk_bf16(v0[0], v0[1]); w.y = cvt_pk_bf16(v0[2], v0[3]); w.z = cvt_pk_bf16(v1[0], v1[1]); w.w = cvt_pk_bf16(v1[2], v1[3]);
                    *(u32x4*)(rowp + C_GA + bj * HALF) = w; }
                asm volatile("" ::: "memory"); }
    }
};
struct EpiOut {
    static constexpr bool PERM = false, AFTER_DRAIN = false;
    const float* xin; float* xout; const float* gate; int tok0;
    __device__ __forceinline__ void operator()(const f32x4 (&acc)[2][2][4][2], const Unit& u, int wr, int wc, int fr, int fq) const {
        const int row0 = u.pm * BM + wr * 64 + fr, col0 = u.pn * BM + wc * 32 + 4 * fq;
        const int b = (tok0 + u.pm * BM) >> 11;
        f32x4 gv[2][2];
#pragma unroll
        for (int bj = 0; bj < 2; ++bj)
#pragma unroll
            for (int n = 0; n < 2; ++n) gv[bj][n] = *(const f32x4*)(gate + (size_t)b * 3072 + col0 + bj * HALF + n * 16);
#pragma unroll
        for (int ai = 0; ai < 2; ++ai)
#pragma unroll
            for (int m = 0; m < 4; ++m) { const size_t off = (size_t)(tok0 + row0 + ai * HALF + m * 16) * 1024 + col0;
#pragma unroll
                for (int bj = 0; bj < 2; ++bj)
#pragma unroll
                    for (int n = 0; n < 2; ++n) { const f32x4 xv = *(const f32x4*)(xin + off + bj * HALF + n * 16);
                        *(f32x4*)(xout + off + bj * HALF + n * 16) = xv + gv[bj][n] * acc[ai][bj][m][n]; }
                asm volatile("" ::: "memory"); }
    }
};

template <class Epi, class Sched, bool ALIGN_EPI, bool SP2, int KC, int LDA, int LDB>
__device__ __forceinline__ void gemm_phase(PG8_LAS unsigned char* lds, int tid_in, const Gemm g, const Sched& S, const Epi& E) {
    int tid_ = tid_in; asm volatile("" : "+v"(tid_));
    const int tid = tid_, wid = __builtin_amdgcn_readfirstlane(tid >> 6), lane = tid & 63, wr = wid >> 2, wc = wid & 3, fr = lane & 15, fq = lane >> 4;
    constexpr int K = KC, nt = K / BK;
    unsigned voffA[2], voffB[2];
#pragma unroll
    for (int i = 0; i < 2; ++i) { int R, C; stage_rc(tid * 16 + i * 8192, R, C); const int Rb = Epi::PERM ? ((R & ~31) + perm32(R & 31)) : R;
        voffA[i] = (unsigned)(R * LDA + C) * 2u; voffB[i] = (unsigned)(Rb * LDB + C) * 2u; }
    constexpr size_t kstep = (size_t)(BK * 2);
    constexpr size_t hstepA = (size_t)HALF * LDA * 2, hstepB = (size_t)HALF * LDB * 2;
    constexpr size_t tstepA = 2 * hstepA, tstepB = 2 * hstepB;
    const unsigned ldsw = (unsigned)wid * 1024u;
    const int aoff = lds_byte(wr * 64 + fr, fq * 8), boff = lds_byte(wc * 32 + fr, fq * 8);
#define PG8_SA(b, h) (((b) * 2 + (h)) * HTB)
#define PG8_SB(b, h) ((4 + (b) * 2 + (h)) * HTB)
#define PG8_STAGE(bufoff, gbase, voff) do { _Pragma("unroll") for (int _i = 0; _i < 2; ++_i) \
        __builtin_amdgcn_global_load_lds((const unsigned*)((const char*)(gbase) + (voff)[_i]), (PG8_LAS unsigned*)(lds + (bufoff) + ldsw + _i * 8192), 16, 0, 0); } while (0)
#define PG8_LDA(dst, b, h) do { _Pragma("unroll") for (int m = 0; m < 4; ++m) _Pragma("unroll") for (int k = 0; k < 2; ++k) dst[m][k] = *(const PG8_LAS bf16x8*)(lds + PG8_SA(b, h) + aoff + m * 2048 + k * 1024); } while (0)
#define PG8_LDB(dst, b, h) do { _Pragma("unroll") for (int n = 0; n < 2; ++n) _Pragma("unroll") for (int k = 0; k < 2; ++k) dst[n][k] = *(const PG8_LAS bf16x8*)(lds + PG8_SB(b, h) + boff + n * 2048 + k * 1024); } while (0)
#define PG8_MMA(ai, bj, At, Bt) do { __builtin_amdgcn_s_setprio(1); _Pragma("unroll") for (int m = 0; m < 4; ++m) _Pragma("unroll") for (int n = 0; n < 2; ++n) _Pragma("unroll") for (int k = 0; k < 2; ++k) \
        acc[ai][bj][m][n] = __builtin_amdgcn_mfma_f32_16x16x32_bf16(Bt[n][k], At[m][k], acc[ai][bj][m][n], 0, 0, 0); __builtin_amdgcn_s_setprio(0); } while (0)
#define PG8_WAIT_V(n) asm volatile("s_waitcnt vmcnt(" #n ")" ::: "memory")
#define PG8_WAIT_L(n) asm volatile("s_waitcnt lgkmcnt(" #n ")" ::: "memory")
#define PG8_BAR __builtin_amdgcn_s_barrier()
#define PG8_SCHED __builtin_amdgcn_sched_barrier(0)
    Unit cur, nxt; int ui = 0;
    if (!S.next(0, cur)) return;
    f32x4 acc[2][2][4][2];
#pragma unroll
    for (int a = 0; a < 2; ++a)
#pragma unroll
        for (int b = 0; b < 2; ++b)
#pragma unroll
            for (int m = 0; m < 4; ++m)
#pragma unroll
                for (int n = 0; n < 2; ++n) acc[a][b][m][n] = (f32x4){0.f, 0.f, 0.f, 0.f};
    bf16x8 At[4][2], B0[2][2], B1[2][2];
    const char* cA = (const char*)g.A + (size_t)cur.pm * tstepA; const char* cB = (const char*)g.Bt + (size_t)cur.pn * tstepB;
    S.a_ready(cur);
    if constexpr (SP2) {
        PG8_STAGE(PG8_SB(0, 0), cB, voffB); PG8_STAGE(PG8_SB(0, 1), cB + hstepB, voffB); PG8_STAGE(PG8_SA(0, 0), cA, voffA); PG8_STAGE(PG8_SA(0, 1), cA + hstepA, voffA);
        if (wr == 1) PG8_BAR;
        PG8_WAIT_V(2); PG8_BAR;
        PG8_STAGE(PG8_SB(1, 0), cB + kstep, voffB); PG8_STAGE(PG8_SA(1, 0), cA + kstep, voffA); PG8_STAGE(PG8_SB(1, 1), cB + hstepB + kstep, voffB);
        PG8_WAIT_V(6); PG8_BAR;
    } else {
        PG8_STAGE(PG8_SB(0, 0), cB, voffB); PG8_STAGE(PG8_SA(0, 0), cA, voffA); PG8_STAGE(PG8_SB(0, 1), cB + hstepB, voffB); PG8_STAGE(PG8_SA(0, 1), cA + hstepA, voffA);
        if (wr == 1) PG8_BAR;
        PG8_WAIT_V(4); PG8_BAR;
        PG8_STAGE(PG8_SB(1, 0), cB + kstep, voffB); PG8_STAGE(PG8_SA(1, 0), cA + kstep, voffA); PG8_STAGE(PG8_SB(1, 1), cB + hstepB + kstep, voffB);
        PG8_WAIT_V(6); PG8_BAR;
    }
    for (;;) {
        const bool has_next = S.next(ui + 1, nxt);
        const char* nA = has_next ? (const char*)g.A + (size_t)nxt.pm * tstepA : cA; const char* nB = has_next ? (const char*)g.Bt + (size_t)nxt.pn * tstepB : cB;
        for (int t = 0; t < nt; t += 2) {
            const bool last = (t == nt - 2);
            const char* a1 = cA + (size_t)(t + 1) * kstep;
            const char* a2 = last ? nA : cA + (size_t)(t + 2) * kstep; const char* b2 = last ? nB : cB + (size_t)(t + 2) * kstep;
            const char* a3 = a2 + kstep; const char* b3 = b2 + kstep;
            if (last && has_next) S.a_ready(nxt);
            if constexpr (SP2) {
            PG8_LDB(B0, 0, 0); PG8_LDB(B1, 0, 1); PG8_SCHED; PG8_LDA(At, 0, 0); PG8_STAGE(PG8_SA(1, 1), a1 + hstepA, voffA);
            PG8_WAIT_V(8); PG8_WAIT_L(0); PG8_BAR; PG8_MMA(0, 0, At, B0); PG8_MMA(0, 1, At, B1); PG8_BAR; PG8_SCHED;
            PG8_LDA(At, 0, 1); PG8_STAGE(PG8_SB(0, 0), b2, voffB); PG8_STAGE(PG8_SB(0, 1), b2 + hstepB, voffB); PG8_STAGE(PG8_SA(0, 0), a2, voffA);
            PG8_WAIT_V(8); PG8_WAIT_L(0); PG8_BAR; PG8_MMA(1, 0, At, B0); PG8_MMA(1, 1, At, B1); PG8_BAR; PG8_SCHED;
            PG8_LDB(B0, 1, 0); PG8_LDB(B1, 1, 1); PG8_SCHED; PG8_LDA(At, 1, 0); PG8_STAGE(PG8_SA(0, 1), a2 + hstepA, voffA);
            PG8_WAIT_V(8); PG8_WAIT_L(0); PG8_BAR; PG8_MMA(0, 0, At, B0); PG8_MMA(0, 1, At, B1); PG8_BAR; PG8_SCHED;
            PG8_LDA(At, 1, 1); PG8_STAGE(PG8_SB(1, 0), b3, voffB); PG8_STAGE(PG8_SB(1, 1), b3 + hstepB, voffB); PG8_STAGE(PG8_SA(1, 0), a3, voffA);
            PG8_WAIT_V(8); PG8_WAIT_L(0); PG8_BAR; PG8_MMA(1, 0, At, B0); PG8_MMA(1, 1, At, B1); PG8_BAR; PG8_SCHED;
            } else {
            PG8_LDB(B0, 0, 0); PG8_SCHED; PG8_LDA(At, 0, 0); PG8_STAGE(PG8_SA(1, 1), a1 + hstepA, voffA);
            PG8_WAIT_L(8); PG8_BAR; PG8_WAIT_L(0); PG8_MMA(0, 0, At, B0); PG8_BAR; PG8_SCHED;
            PG8_LDB(B1, 0, 1); PG8_STAGE(PG8_SB(0, 0), b2, voffB);
            PG8_BAR; PG8_WAIT_L(0); PG8_MMA(0, 1, At, B1); PG8_BAR;
            PG8_LDA(At, 0, 1); PG8_STAGE(PG8_SA(0, 0), a2, voffA);
            PG8_BAR; PG8_WAIT_L(0); PG8_MMA(1, 0, At, B0); PG8_BAR; PG8_SCHED;
            PG8_STAGE(PG8_SB(0, 1), b2 + hstepB, voffB);
            PG8_WAIT_V(6); PG8_BAR; PG8_MMA(1, 1, At, B1); PG8_BAR;
            PG8_LDB(B0, 1, 0); PG8_SCHED; PG8_LDA(At, 1, 0); PG8_STAGE(PG8_SA(0, 1), a2 + hstepA, voffA);
            PG8_WAIT_L(8); PG8_BAR; PG8_WAIT_L(0); PG8_MMA(0, 0, At, B0); PG8_BAR; PG8_SCHED;
            PG8_LDB(B1, 1, 1); PG8_STAGE(PG8_SB(1, 0), b3, voffB);
            PG8_BAR; PG8_WAIT_L(0); PG8_MMA(0, 1, At, B1); PG8_BAR;
            PG8_LDA(At, 1, 1); PG8_STAGE(PG8_SA(1, 0), a3, voffA);
            PG8_BAR; PG8_WAIT_L(0); PG8_MMA(1, 0, At, B0); PG8_BAR; PG8_SCHED;
            PG8_STAGE(PG8_SB(1, 1), b3 + hstepB, voffB);
            PG8_WAIT_V(6); PG8_BAR; PG8_MMA(1, 1, At, B1); PG8_BAR;
            }
        }
        if constexpr (ALIGN_EPI) { if (wr == 0) PG8_BAR; }
        if constexpr (!Epi::AFTER_DRAIN) { E(acc, cur, wr, wc, fr, fq); S.done(cur); }
        if (!has_next) break;
#pragma unroll
        for (int a = 0; a < 2; ++a)
#pragma unroll
            for (int b = 0; b < 2; ++b)
#pragma unroll
                for (int m = 0; m < 4; ++m)
#pragma unroll
                    for (int n = 0; n < 2; ++n) acc[a][b][m][n] = (f32x4){0.f, 0.f, 0.f, 0.f};
        cur = nxt; cA = nA; cB = nB; ++ui;
        if constexpr (ALIGN_EPI) { if (wr == 1) PG8_BAR; }
    }
    PG8_WAIT_V(0);
    if constexpr (!ALIGN_EPI) { if (wr == 0) PG8_BAR; }
    PG8_BAR;
    if constexpr (Epi::AFTER_DRAIN) { E.fused(acc, cur, wr, wc, fr, fq, lds, wid, lane); S.done(cur); }
#undef PG8_SA
#undef PG8_SB
#undef PG8_STAGE
#undef PG8_LDA
#undef PG8_LDB
#undef PG8_MMA
#undef PG8_WAIT_V
#undef PG8_WAIT_L
#undef PG8_BAR
#undef PG8_SCHED
}
}

#define GAS __attribute__((address_space(1)))
#define LAS __attribute__((address_space(3)))
typedef unsigned short bf16;
typedef unsigned v4u __attribute__((ext_vector_type(4)));
typedef float f32x4 __attribute__((ext_vector_type(4)));
typedef short bf16x8 __attribute__((ext_vector_type(8)));
typedef GAS unsigned gu32;
typedef GAS unsigned long long gu64;
#define RLX_AGENT __ATOMIC_RELAXED, __HIP_MEMORY_SCOPE_AGENT
#define LDS_WAIT() asm volatile("s_waitcnt lgkmcnt(0)" ::: "memory")
#define VM_WAIT() asm volatile("s_waitcnt vmcnt(0)" ::: "memory")
__device__ __forceinline__ unsigned long long rt() { return __builtin_amdgcn_s_memrealtime(); }
__device__ __forceinline__ unsigned f2bf(float f) { unsigned u = __builtin_bit_cast(unsigned, f); return (u + 0x7fffu + ((u >> 16) & 1u)) >> 16; }
__device__ __forceinline__ unsigned pk2(float lo, float hi) { return f2bf(lo) | (f2bf(hi) << 16); }

#define XB_TMO      128
#define XB_XCNT(j)  (256  + 64 * (j))
#define XB_XSUB(j)  (1280 + 64 * (j))
#define XB_XGEN(j)  (2304 + 64 * (j))
#define XB_TOP      3328
#define XB_TOPGEN   3392
#define XCD_BAR_WORDS 3456
#define XB_SPIN_CAP (1u << 18)

__device__ __forceinline__ unsigned xb_ld(unsigned* p)              { return __hip_atomic_load(p, __ATOMIC_RELAXED, __HIP_MEMORY_SCOPE_AGENT); }
__device__ __forceinline__ unsigned xb_add(unsigned* p, unsigned v) { return __hip_atomic_fetch_add(p, v, __ATOMIC_RELAXED, __HIP_MEMORY_SCOPE_AGENT); }
__device__ __forceinline__ unsigned xb_xcc_id() { return (unsigned)__builtin_amdgcn_s_getreg((3 << 11) | 20) & 0xFu; }
#define XB_SPIN(cond, bar) do { unsigned _sp = 0; while (cond) { __builtin_amdgcn_s_sleep(1); \
    if ((++_sp & 255u) == 0u) { if (xb_ld(&(bar)[XB_TMO])) break; if (_sp > XB_SPIN_CAP) { atomicAdd(&(bar)[XB_TMO], 1u); break; } } } } while (0)

struct XcdBarrier {
    unsigned* bar; unsigned x;
    volatile LAS unsigned* st;
};

__device__ __forceinline__ XcdBarrier xcd_barrier_post(unsigned* bar, volatile LAS unsigned* st) {
    XcdBarrier b; b.bar = bar; b.x = xb_xcc_id(); b.st = st;
    if (threadIdx.x == 0) (void)xb_add(&bar[XB_XCNT(b.x)], 1u);
    return b;
}
__device__ __forceinline__ void xcd_barrier_complete(unsigned* bar, unsigned x, unsigned& nloc, unsigned& nx) {
    const unsigned G = gridDim.x * gridDim.y * gridDim.z;
    unsigned sum, cnt, mine, sp = 0u;
    for (;;) {
        sum = 0u; cnt = 0u; mine = 0u;
#pragma unroll
        for (unsigned j = 0; j < 16; ++j) { const unsigned c = xb_ld(&bar[XB_XCNT(j)]); sum += c; cnt += (c > 0u) ? 1u : 0u; mine = (j == x) ? c : mine; }
        if (sum == G) break;
        __builtin_amdgcn_s_sleep(1);
        if ((++sp & 255u) == 0u) { if (xb_ld(&bar[XB_TMO])) break; if (sp > XB_SPIN_CAP) { atomicAdd(&bar[XB_TMO], 1u); break; } }
    }
    nloc = mine > 0u ? mine : 1u; nx = cnt > 0u ? cnt : 1u;
}

__device__ __forceinline__ void xcd_barrier(const XcdBarrier& b) {
    asm volatile("s_waitcnt vmcnt(0)" ::: "memory");
    __syncthreads();
    if (threadIdx.x == 0) {
        unsigned* bar = b.bar;
        __builtin_amdgcn_s_waitcnt(0);
        unsigned nloc = b.st[0], nx = b.st[1];
        if (nloc == 0u) { xcd_barrier_complete(bar, b.x, nloc, nx); b.st[0] = nloc; b.st[1] = nx; }
        const unsigned old = xb_add(&bar[XB_XSUB(b.x)], 1u);
        const unsigned gen = old / nloc;
        if (old + 1u == (gen + 1u) * nloc) {
            __builtin_amdgcn_fence(__ATOMIC_RELEASE, "agent");
            asm volatile("s_waitcnt vmcnt(0)" ::: "memory");
            const unsigned og = xb_add(&bar[XB_TOP], 1u);
            const unsigned tg = og / nx;
            if (og + 1u == (tg + 1u) * nx) xb_add(&bar[XB_TOPGEN], 1u);
            else XB_SPIN(xb_ld(&bar[XB_TOPGEN]) == tg, bar);
            __builtin_amdgcn_fence(__ATOMIC_ACQUIRE, "agent");
            xb_add(&bar[XB_XGEN(b.x)], 1u);
            asm volatile("s_waitcnt vmcnt(0)" ::: "memory");
        } else {
            XB_SPIN(xb_ld(&bar[XB_XGEN(b.x)]) == gen, bar);
            __builtin_amdgcn_fence(__ATOMIC_ACQUIRE, "agent");
            asm volatile("s_waitcnt vmcnt(0)" ::: "memory");
        }
    }
    __syncthreads();
}


namespace att {
typedef unsigned short bf16;
typedef short bf16x8 __attribute__((ext_vector_type(8)));
typedef short s16x4 __attribute__((ext_vector_type(4)));
typedef float f32x16 __attribute__((ext_vector_type(16)));
typedef float f32x4 __attribute__((ext_vector_type(4)));
typedef unsigned u32x4 __attribute__((ext_vector_type(4)));
constexpr float SCALE = 0.08838834764831845f;
constexpr int NW = 8, QBLK = 32, KVBLK = 64, QB = NW * QBLK, D = 128, LDP = 11264;
constexpr int SHM_V = KVBLK * D * 2, SHM_K = KVBLK * D * 2;
constexpr int LDS_BYTES = 2 * SHM_V + 2 * SHM_K + NW * 64 * 4;
constexpr float THR = 8.f;
constexpr bool SK = true;

#define KSWZ(row, colB) ((row) * 256 + ((colB) ^ (((row) & 7) << 4)))
#define SBAR() __builtin_amdgcn_sched_barrier(0)
__device__ __forceinline__ int v_st(int k, int c) { const int kk = (k & ~0xC) | ((k & 4) << 1) | ((k & 8) >> 1); return ((kk >> 3) * 4 + (c >> 5)) * 512 + ((kk & 7) * 32 + (c & 31)) * 2; }
__device__ __forceinline__ int v_rd_base(int lane) { return ((lane & 3) << 3) | (((lane >> 2) & 3) << 6) | (((lane >> 4) & 1) << 5) | (((lane >> 5) & 1) << 8); }
constexpr int v_rd_off(int d0, int ks, int half) { return d0 * 512 + ks * 4096 + half * 2048; }
__device__ __forceinline__ int crow(int r, int hi) { return (r & 3) + 8 * (r >> 2) + 4 * hi; }
__device__ __forceinline__ unsigned cvtpk(float lo, float hi) { unsigned r; asm volatile("v_cvt_pk_bf16_f32 %0, %1, %2" : "=v"(r) : "v"(lo), "v"(hi)); return r; }
__device__ __forceinline__ bf16x8 load8(const bf16* p) { return *reinterpret_cast<const bf16x8*>(p); }
__device__ __forceinline__ void mask_tile(f32x16& p0, f32x16& p1, int dq, unsigned W) {
    const float NEG = -__builtin_inff();
#pragma unroll
    for (int r = 0; r < 16; ++r) {
        const int c = (r & 3) + 8 * (r >> 2);
        if ((unsigned)(dq - c) >= W) p0[r] = NEG;
        if ((unsigned)(dq - c - 32) >= W) p1[r] = NEG;
    }
}
__device__ __forceinline__ void partialSM(f32x16& p0, f32x16& p1, float& m_reg, float& mn, float& alpha) {
    float pmax = p0[0]; for (int r = 1; r < 16; ++r) pmax = fmaxf(pmax, p0[r]); for (int r = 0; r < 16; ++r) pmax = fmaxf(pmax, p1[r]);
    { auto rr = __builtin_amdgcn_permlane32_swap(__float_as_uint(pmax), __float_as_uint(pmax), false, false);
      pmax = fmaxf(__uint_as_float(rr[0]), __uint_as_float(rr[1])); }
    constexpr float C2 = 1.4426950408889634f * SCALE;
    if (__builtin_expect(__all((pmax - m_reg) * SCALE <= THR), 1)) { mn = m_reg; alpha = 1.f; }
    else { mn = fmaxf(m_reg, pmax); alpha = __builtin_amdgcn_exp2f((m_reg - mn) * C2); m_reg = mn; }
    const float mnL = -mn * C2;
    for (int r = 0; r < 16; ++r) p0[r] = fmaf(p0[r], C2, mnL); for (int r = 0; r < 16; ++r) p1[r] = fmaf(p1[r], C2, mnL);
    for (int r = 0; r < 16; ++r) p0[r] = __builtin_amdgcn_exp2f(p0[r]);
}
__device__ __forceinline__ void finishSM(f32x16& p0, f32x16& p1, float alpha, float& l_reg, bf16x8& pa0, bf16x8& pa1, bf16x8& pa2, bf16x8& pa3) {
    for (int r = 0; r < 16; ++r) p1[r] = __builtin_amdgcn_exp2f(p1[r]);
    float ps = 0; for (int r = 0; r < 16; ++r) ps += p0[r]; for (int r = 0; r < 16; ++r) ps += p1[r];
    { auto rr = __builtin_amdgcn_permlane32_swap(__float_as_uint(ps), __float_as_uint(ps), false, false);
      ps = __uint_as_float(rr[0]) + __uint_as_float(rr[1]); }
    l_reg = l_reg * alpha + ps;
#define PK4(P, B_, OUT) do { unsigned a0 = cvtpk(P[B_+0], P[B_+1]), a1 = cvtpk(P[B_+2], P[B_+3]);                          \
        unsigned b0 = cvtpk(P[B_+4], P[B_+5]), b1 = cvtpk(P[B_+6], P[B_+7]);                                             \
        auto r0 = __builtin_amdgcn_permlane32_swap(a0, b0, false, false); auto r1 = __builtin_amdgcn_permlane32_swap(a1, b1, false, false); \
        u32x4 w = {r0[0], r1[0], r0[1], r1[1]}; OUT = *reinterpret_cast<bf16x8*>(&w); } while (0)
    PK4(p0, 0, pa0); PK4(p0, 8, pa1); PK4(p1, 0, pa2); PK4(p1, 8, pa3);
#undef PK4
}
template <int KB>
__device__ __forceinline__ void qkt(f32x16& p0, f32x16& p1, const char* K_lds, int r32, int hi, const bf16x8* qr, bool act) {
    if (SK && !act) { const float NEG = -__builtin_inff();
#pragma unroll
        for (int r = 0; r < 16; ++r) { p0[r] = NEG; p1[r] = NEG; } return; }
    p0 = f32x16{}; p1 = f32x16{};
    const char* kb[4];
#pragma unroll
    for (int dd = 0; dd < 4; ++dd) kb[dd] = K_lds + KB * SHM_K + KSWZ(r32, (dd * 16 + hi * 8) * 2);
#pragma unroll
    for (int d0 = 0; d0 < 8; ++d0) { const char* a = kb[d0 & 3] + (d0 >> 2) * 128;
        bf16x8 b0 = *reinterpret_cast<const bf16x8*>(a);
        bf16x8 b1 = *reinterpret_cast<const bf16x8*>(a + 32 * 256);
        p0 = __builtin_amdgcn_mfma_f32_32x32x16_bf16(b0, qr[d0], p0, 0, 0, 0);
        p1 = __builtin_amdgcn_mfma_f32_32x32x16_bf16(b1, qr[d0], p1, 0, 0, 0); }
}
template <int VB>
__device__ __forceinline__ void pv_tile(f32x16* o, int vb0, bf16x8 pa0, bf16x8 pa1, bf16x8 pa2, bf16x8 pa3, bool act) {
    if (SK && !act) return;
#define TRRD(dst, off) asm volatile("ds_read_b64_tr_b16 %0, %1 offset:%2" : "=&v"(dst) : "v"(vb0), "i"(off) : "memory")
#define PV_D0(d0) do { s16x4 l0, l1, l2, l3, h0, h1, h2, h3; constexpr int b_ = VB * SHM_V + v_rd_off(d0, 0, 0); \
        TRRD(l0, b_); TRRD(h0, b_ + 2048); TRRD(l1, b_ + 4096); TRRD(h1, b_ + 6144); TRRD(l2, b_ + 8192); TRRD(h2, b_ + 10240); TRRD(l3, b_ + 12288); TRRD(h3, b_ + 14336); \
        asm volatile("s_waitcnt lgkmcnt(0)" ::: "memory"); SBAR();   \
        o[d0] = __builtin_amdgcn_mfma_f32_32x32x16_bf16(pa0, (bf16x8){l0[0], l0[1], l0[2], l0[3], h0[0], h0[1], h0[2], h0[3]}, o[d0], 0, 0, 0);   \
        o[d0] = __builtin_amdgcn_mfma_f32_32x32x16_bf16(pa1, (bf16x8){l1[0], l1[1], l1[2], l1[3], h1[0], h1[1], h1[2], h1[3]}, o[d0], 0, 0, 0);   \
        o[d0] = __builtin_amdgcn_mfma_f32_32x32x16_bf16(pa2, (bf16x8){l2[0], l2[1], l2[2], l2[3], h2[0], h2[1], h2[2], h2[3]}, o[d0], 0, 0, 0);   \
        o[d0] = __builtin_amdgcn_mfma_f32_32x32x16_bf16(pa3, (bf16x8){l3[0], l3[1], l3[2], l3[3], h3[0], h3[1], h3[2], h3[3]}, o[d0], 0, 0, 0); } while (0)
    PV_D0(0); PV_D0(1); PV_D0(2); PV_D0(3);
#undef PV_D0
#undef TRRD
}
struct BlockRef { bf16* Q; float* L; int P0, dsh, lmask, lsh, g2; };
constexpr int KOFF = 1536, VOFF = 3072;
__device__ __forceinline__ int tokoff(const BlockRef& r, int v) { return ((v & r.lmask) << r.dsh) + (v >> r.lsh); }
struct Seam { bf16x8 qr[8]; bf16x8 st_v0, st_v1, st_k0, st_k1; };
__device__ __forceinline__ int blk_jlo(const BlockRef& r) { const int lowk = r.g2 ? r.P0 : r.P0 - 128; return lowk > 0 ? lowk / KVBLK : 0; }
#define ROWC(ref, p, k0, rr) ((p) + (size_t)tokoff(ref, (k0) + (rr)) * LDP + sc)
#define VMW() asm volatile("s_waitcnt vmcnt(0)" ::: "memory")
#define VMWN(n) asm volatile("s_waitcnt vmcnt(%0)" :: "i"(n) : "memory")
#define SLOAD_H(ref, k0) do { const bf16* r0_ = ROWC(ref, (ref).Q, k0, sr); const bf16* r1_ = ROWC(ref, (ref).Q, k0, 32 + sr);              \
                              S.st_v0 = load8(r0_ + VOFF); S.st_v1 = load8(r1_ + VOFF); S.st_k0 = load8(r0_ + KOFF); S.st_k1 = load8(r1_ + KOFF); } while (0)
#define SWRITE_HK(bf) do { *(bf16x8*)(K_lds + (bf) * SHM_K + kws) = S.st_k0; *(bf16x8*)(K_lds + (bf) * SHM_K + kws + 32 * 256) = S.st_k1; } while (0)
#define SWRITE_HV(bf) do { *(bf16x8*)(V_lds + (bf) * SHM_V + vst0) = S.st_v0; *(bf16x8*)(V_lds + (bf) * SHM_V + vst1) = S.st_v1; } while (0)
#define SWRITE_H(bf) do { SWRITE_HV(bf); SWRITE_HK(bf); } while (0)
__device__ __forceinline__ void swa_prime(const BlockRef& cur, char* lds, Seam& S, int tid) {
    const int wid = __builtin_amdgcn_readfirstlane(tid >> 6), lane = tid & 63, r32 = lane & 31, hi = lane >> 5;
    const int sr = tid >> 4, sc = (tid & 15) * 8, kws = KSWZ(sr, sc * 2); char* K_lds = lds + 2 * SHM_V;
    const int kb0 = blk_jlo(cur) * KVBLK;
    { const bf16* qrow = cur.Q + (size_t)tokoff(cur, cur.P0 + wid * QBLK + r32) * LDP + hi * 8;
#pragma unroll
      for (int d0 = 0; d0 < 8; ++d0) S.qr[d0] = load8(qrow + d0 * 16); }
    SLOAD_H(cur, kb0); VMW(); SWRITE_HK(0);
    __syncthreads();
}
__device__ __forceinline__ void swa_block(const BlockRef& cur, const BlockRef& nxt, char* lds, Seam& S, int tid_in, bool dry = false) {
    int tid = tid_in; asm volatile("" : "+v"(tid));
    const int wid = __builtin_amdgcn_readfirstlane(tid >> 6), lane = tid & 63, r32 = lane & 31, hi = lane >> 5;
    const int j_lo = blk_jlo(cur), j_hi = (cur.P0 + QB - 1) / KVBLK + 1;
    const int NT = j_hi - j_lo;
    const int kbn = blk_jlo(nxt) * KVBLK;
    const int qlo = cur.P0 + wid * QBLK, qm = qlo + r32 - 4 * hi;
    const unsigned Wl = cur.g2 ? (unsigned)(((qlo + r32) & 127) + 1) : 129u;
    const int wklo = cur.g2 ? (qlo & ~127) : qlo - 128;
    const int wklo_last = cur.g2 ? (qlo & ~127) : qlo - 97;
    char* V_lds = lds; char* K_lds = lds + 2 * SHM_V;
    float* wsl = (float*)(lds + 2 * SHM_V + 2 * SHM_K) + wid * 64; float* li_l = wsl, * al_l = wsl + 32;
    float m_reg = -1e30f, l_reg = 0; f32x16 o[4] = {};
    const int sr = tid >> 4, sc = (tid & 15) * 8, vst0 = v_st(sr, sc), vst1 = v_st(32 + sr, sc), kws = KSWZ(sr, sc * 2);
    const int vb0 = (int)(uintptr_t)V_lds + v_rd_base(lane);
#define RESC(a) do { if (__any((a) < 1.f)) { if (hi == 0) al_l[r32] = (a); asm volatile("s_waitcnt lgkmcnt(0)" ::: "memory");              \
                     for (int d_ = 0; d_ < 4; ++d_) for (int r = 0; r < 16; ++r) o[d_][r] *= al_l[crow(r, hi)]; } } while (0)
#define KBASE(t) ((j_lo + (t)) * KVBLK)
#define ACT(t) (KBASE(t) <= qlo + QBLK - 1 && KBASE(t) + KVBLK - 1 >= wklo)
#define MASKT(P0_, P1_, t) do { const int kb_ = KBASE(t); if ((!SK || ACT(t)) && (kb_ + KVBLK - 1 > qlo || kb_ < wklo_last)) mask_tile(P0_, P1_, qm - kb_, Wl); } while (0)
    constexpr int NQL = 8;
#define SEAM_K0() do { VMWN(NQL); SWRITE_HK(0); SBAR(); } while (0)
    f32x16 pA0, pA1, pB0, pB1; float mnA, mnB, alA, alB; bf16x8 pa0, pa1, pa2, pa3;
    SWRITE_HV(0); SBAR();
    if (NT > 1) { SLOAD_H(cur, KBASE(1)); }
    SBAR(); qkt<0>(pA0, pA1, K_lds, r32, hi, S.qr, ACT(0));
    MASKT(pA0, pA1, 0); partialSM(pA0, pA1, m_reg, mnA, alA);
    if (NT > 1) { VMW(); SWRITE_H(1); }
    __syncthreads();
#define HALF_STEP(PX0, PX1, mnX, alX, PY0, PY1, alY, t, KB, VB, SB) do {                                                      \
        SBAR(); qkt<KB>(PX0, PX1, K_lds, r32, hi, S.qr, ACT(t));                                             \
        finishSM(PY0, PY1, alY, l_reg, pa0, pa1, pa2, pa3); SBAR();                                                           \
        if ((t) + 1 < NT) { SLOAD_H(cur, KBASE((t) + 1)); SBAR(); }                                               \
        pv_tile<VB>(o, vb0, pa0, pa1, pa2, pa3, ACT((t) - 1)); MASKT(PX0, PX1, (t)); partialSM(PX0, PX1, m_reg, mnX, alX);                                        \
        __syncthreads();                                                                                                      \
        if ((t) + 1 < NT) { VMW(); SWRITE_H(SB); }                                                                          \
        RESC(alX); __syncthreads(); } while (0)
    for (int t = 1; t + 1 < NT; t += 2) {
        HALF_STEP(pB0, pB1, mnB, alB, pA0, pA1, alA, t, 1, 0, 0);
        HALF_STEP(pA0, pA1, mnA, alA, pB0, pB1, alB, t + 1, 0, 1, 1);
    }
    const bool even = (NT & 1) == 0;
    if (even) { SBAR(); qkt<1>(pB0, pB1, K_lds, r32, hi, S.qr, ACT(NT - 1)); SBAR(); }
    SLOAD_H(nxt, kbn); SBAR();
    { const bf16* qrow = nxt.Q + (size_t)tokoff(nxt, nxt.P0 + wid * QBLK + r32) * LDP + hi * 8;
#pragma unroll
      for (int d0 = 0; d0 < 8; ++d0) S.qr[d0] = load8(qrow + d0 * 16); }
    SBAR();
    finishSM(pA0, pA1, alA, l_reg, pa0, pa1, pa2, pa3); SBAR();
    pv_tile<0>(o, vb0, pa0, pa1, pa2, pa3, ACT(even ? NT - 2 : NT - 1));
    if (even) { MASKT(pB0, pB1, NT - 1); partialSM(pB0, pB1, m_reg, mnB, alB); __syncthreads(); RESC(alB);
        finishSM(pB0, pB1, alB, l_reg, pa0, pa1, pa2, pa3); SBAR(); pv_tile<1>(o, vb0, pa0, pa1, pa2, pa3, ACT(NT - 1)); }
    SBAR(); SEAM_K0();
    if (hi == 0) { li_l[r32] = l_reg; if (!dry) cur.L[(size_t)tokoff(cur, qlo + r32) * 12] = m_reg * SCALE + __logf(l_reg); }
    asm volatile("s_waitcnt lgkmcnt(0)" ::: "memory");
#pragma unroll
    for (int r = 0; r < 16; ++r) { const int orow = crow(r, hi); const float rli = __builtin_amdgcn_rcpf(li_l[orow]);
        bf16* Ow = cur.Q + (size_t)tokoff(cur, qlo + orow) * LDP;
#pragma unroll
        for (int d0 = 0; d0 < 4; ++d0) { const float v = o[d0][r] * rli; const float vn = __uint_as_float((unsigned)__builtin_amdgcn_ds_bpermute((lane ^ 1) << 2, (int)__float_as_uint(v)));
            if ((r32 & 1) == 0 && !dry) *(unsigned*)(Ow + d0 * 32 + r32) = cvtpk(v, vn); } }
    __syncthreads();
#undef RESC
#undef KBASE
#undef ACT
#undef MASKT
#undef SEAM_K0
#undef HALF_STEP
}
#undef ROWC
#undef VMW
#undef VMWN
#undef SLOAD_H
#undef SWRITE_HK
#undef SWRITE_HV
#undef SWRITE_H
#undef KSWZ
#undef SBAR
}


namespace ret {
typedef unsigned short bf16;
typedef short bf16x8 __attribute__((ext_vector_type(8)));
typedef short s16x4 __attribute__((ext_vector_type(4)));
typedef float f32x4 __attribute__((ext_vector_type(4)));
typedef unsigned u32x4 __attribute__((ext_vector_type(4)));
typedef unsigned u32x2 __attribute__((ext_vector_type(2)));
#define RLAS __attribute__((address_space(3)))
constexpr int LDP = 11264, QBO = 0, KBO = 32768, VBO = 65536, PBO = 98304;
__device__ __forceinline__ unsigned cvtpk(float lo, float hi) { unsigned r; asm volatile("v_cvt_pk_bf16_f32 %0, %1, %2" : "=v"(r) : "v"(lo), "v"(hi)); return r; }
__device__ __forceinline__ bf16x8 mk8(unsigned a, unsigned b, unsigned c, unsigned d) { u32x4 w = {a, b, c, d}; return *reinterpret_cast<bf16x8*>(&w); }
#define RET_TR(dst, addr, off) asm volatile("ds_read_b64_tr_b16 %0, %1 offset:%2" : "=&v"(dst) : "v"(addr), "i"(off) : "memory")
#define RET_LW() do { asm volatile("s_waitcnt lgkmcnt(0)" ::: "memory"); __builtin_amdgcn_sched_barrier(0); } while (0)
#define RET_MFMA(a, b, c) __builtin_amdgcn_mfma_f32_16x16x32_bf16(a, b, c, 0, 0, 0)

__device__ __forceinline__ void ret_unit(RLAS unsigned char* lds, int tid_in, const bf16* Pq, bf16* Ho, int eh, int h) {
    int tid = tid_in; asm volatile("" : "+v"(tid));
    const int w = __builtin_amdgcn_readfirstlane(tid >> 6), lane = tid & 63, l15 = lane & 15, q = lane >> 4;
    const float lg = __builtin_log2f(1.0f - __builtin_amdgcn_exp2f(-5.0f - (float)h)), cd = __builtin_amdgcn_exp2f(128.0f * lg);
    const unsigned lb = (unsigned)(size_t)lds;
    const int xr = ((l15 & 3) << 2) | ((l15 >> 2) & 3);
    const unsigned rowA = 256u * l15 + 16u * (unsigned)(q ^ xr);
    const unsigned rowB = 256u * l15 + 16u * (unsigned)((q >> 1) ^ xr) + 8u * (q & 1);
    const unsigned pwr = PBO + 256u * l15 + 16u * (unsigned)((2 * w + (q >> 1)) ^ xr) + 8u * (q & 1);
    const int qq = l15 >> 2, p = lane & 3;
    unsigned trb[2];
#pragma unroll
    for (int t = 0; t < 2; ++t) trb[t] = 256u * (8 * q + 4 * t + qq) + 16u * (unsigned)((p >> 1) ^ ((qq << 2) | ((2 * q + t) & 3))) + 8u * (p & 1);
    const int srow = tid >> 4, sch = tid & 15;
    const unsigned stw = 256u * srow + 16u * (unsigned)(sch ^ ((((srow) & 3) << 2) | ((srow >> 2) & 3)));
    const bf16* gq = Pq + (size_t)srow * LDP + sch * 8;

    f32x4 S[16];
#pragma unroll
    for (int i = 0; i < 16; ++i) S[i] = (f32x4){0.f, 0.f, 0.f, 0.f};

    for (int n = 0; n < 16; ++n) {
        const bf16* gc = gq + (size_t)(128 * n) * LDP;
        f32x4 pt[8], o[8];
#pragma unroll
        for (int i = 0; i < 8; ++i) { pt[i] = (f32x4){0.f, 0.f, 0.f, 0.f}; o[i] = (f32x4){0.f, 0.f, 0.f, 0.f}; }
#pragma unroll
        for (int i = 0; i < 16; ++i) S[i] *= cd;
        bf16x8 vf[4];
#pragma unroll
        for (int half = 0; half < 2; ++half) {
            u32x4 sq[4], sk[4], sv[4];
#pragma unroll
            for (int k = 0; k < 4; ++k) { sq[k] = *(const u32x4*)(gc + (size_t)(32 * k) * LDP + 128 * half); sk[k] = *(const u32x4*)(gc + (size_t)(32 * k) * LDP + 1024 + 128 * half);
                if (half == 0) sv[k] = *(const u32x4*)(gc + (size_t)(32 * k) * LDP + 2048 + 128 * eh); }
            __syncthreads();
#pragma unroll
            for (int k = 0; k < 4; ++k) { *(RLAS u32x4*)(lds + QBO + stw + 8192 * k) = sq[k]; *(RLAS u32x4*)(lds + KBO + stw + 8192 * k) = sk[k];
                if (half == 0) *(RLAS u32x4*)(lds + VBO + stw + 8192 * k) = sv[k]; }
            __syncthreads();
            if (half == 0 && n < 15) {
                const bf16* nx = Pq + (size_t)(128 * (n + 1) + (tid >> 2)) * LDP + (tid & 3) * 64;
                RLAS unsigned* junk = (RLAS unsigned*)(lds + 131072 + w * 256);
                __builtin_amdgcn_global_load_lds((const unsigned*)nx, junk, 4, 0, 0);
                __builtin_amdgcn_global_load_lds((const unsigned*)(nx + 1024), junk, 4, 0, 0);
                if (tid < 256) __builtin_amdgcn_global_load_lds((const unsigned*)(Pq + (size_t)(128 * (n + 1) + (tid >> 1)) * LDP + 2048 + 128 * eh + (tid & 1) * 64), junk, 4, 0, 0);
            }
            if (half == 0) {
                const unsigned va0 = lb + VBO + (trb[0] ^ (32u * w)), va1 = lb + VBO + (trb[1] ^ (32u * w));
                s16x4 l0, h0, l1, h1, l2, h2, l3, h3;
                RET_TR(l0, va0, 0); RET_TR(h0, va1, 0); RET_TR(l1, va0, 8192); RET_TR(h1, va1, 8192); RET_TR(l2, va0, 16384); RET_TR(h2, va1, 16384); RET_TR(l3, va0, 24576); RET_TR(h3, va1, 24576);
                RET_LW();
                vf[0] = (bf16x8){l0[0], l0[1], l0[2], l0[3], h0[0], h0[1], h0[2], h0[3]}; vf[1] = (bf16x8){l1[0], l1[1], l1[2], l1[3], h1[0], h1[1], h1[2], h1[3]};
                vf[2] = (bf16x8){l2[0], l2[1], l2[2], l2[3], h2[0], h2[1], h2[2], h2[3]}; vf[3] = (bf16x8){l3[0], l3[1], l3[2], l3[3], h3[0], h3[1], h3[2], h3[3]};
            }
#pragma unroll
            for (int s = 0; s < 4; ++s) {
                const unsigned ra = rowA ^ (64u * s);
                const bf16x8 ka = *(const RLAS bf16x8*)(lds + KBO + 4096 * w + ra);
#pragma unroll
                for (int ib = 0; ib < 8; ++ib) if (ib >= w) { const bf16x8 qb = *(const RLAS bf16x8*)(lds + QBO + 4096 * ib + ra); pt[ib] = RET_MFMA(ka, qb, pt[ib]); }
            }
#pragma unroll
            for (int s = 0; s < 4; ++s) {
                const f32x4 t0 = S[8 * half + 2 * s], t1 = S[8 * half + 2 * s + 1];
                const bf16x8 tf = mk8(cvtpk(t0[0], t0[1]), cvtpk(t0[2], t0[3]), cvtpk(t1[0], t1[1]), cvtpk(t1[2], t1[3]));
                const unsigned rb0 = rowB ^ (64u * s), rb1 = rb0 ^ 32u;
#pragma unroll
                for (int ib = 0; ib < 8; ++ib) { const u32x2 a0 = *(const RLAS u32x2*)(lds + QBO + 4096 * ib + rb0), a1 = *(const RLAS u32x2*)(lds + QBO + 4096 * ib + rb1);
                    o[ib] = RET_MFMA(tf, mk8(a0.x, a0.y, a1.x, a1.y), o[ib]); }
            }
#pragma unroll
            for (int dtl = 0; dtl < 8; ++dtl) {
                const unsigned ka0 = lb + KBO + (trb[0] ^ (32u * dtl)), ka1 = lb + KBO + (trb[1] ^ (32u * dtl));
                s16x4 l0, h0, l1, h1, l2, h2, l3, h3;
                RET_TR(l0, ka0, 0); RET_TR(h0, ka1, 0); RET_TR(l1, ka0, 8192); RET_TR(h1, ka1, 8192); RET_TR(l2, ka0, 16384); RET_TR(h2, ka1, 16384); RET_TR(l3, ka0, 24576); RET_TR(h3, ka1, 24576);
                RET_LW();
                f32x4 acc = S[8 * half + dtl];
                acc = RET_MFMA(((bf16x8){l0[0], l0[1], l0[2], l0[3], h0[0], h0[1], h0[2], h0[3]}), vf[0], acc);
                acc = RET_MFMA(((bf16x8){l1[0], l1[1], l1[2], l1[3], h1[0], h1[1], h1[2], h1[3]}), vf[1], acc);
                acc = RET_MFMA(((bf16x8){l2[0], l2[1], l2[2], l2[3], h2[0], h2[1], h2[2], h2[3]}), vf[2], acc);
                acc = RET_MFMA(((bf16x8){l3[0], l3[1], l3[2], l3[3], h3[0], h3[1], h3[2], h3[3]}), vf[3], acc);
                S[8 * half + dtl] = acc;
            }
        }
#pragma unroll
        for (int ib = 0; ib < 8; ++ib) {
            f32x4 v = pt[ib];
            if (ib < w) v = (f32x4){0.f, 0.f, 0.f, 0.f};
            else if (ib == w) {
#pragma unroll
                for (int r = 0; r < 4; ++r) if (4 * q + r > l15) v[r] = 0.f; }
            u32x2 pw; pw.x = cvtpk(v[0], v[1]); pw.y = cvtpk(v[2], v[3]);
            *(RLAS u32x2*)(lds + pwr + 4096 * ib) = pw;
        }
        __syncthreads();
#pragma unroll
        for (int ib = 0; ib < 8; ++ib)
#pragma unroll
            for (int ks = 0; ks <= ib / 2; ++ks) { const bf16x8 pb = *(const RLAS bf16x8*)(lds + PBO + 4096 * ib + (rowA ^ (64u * ks))); o[ib] = RET_MFMA(vf[ks], pb, o[ib]); }
        bf16* orow = Ho + (size_t)(128 * n + l15) * 1024 + 16 * w + 4 * q;
#pragma unroll
        for (int ib = 0; ib < 8; ++ib) { u32x2 ow; ow.x = cvtpk(o[ib][0], o[ib][1]); ow.y = cvtpk(o[ib][2], o[ib][3]); *(u32x2*)(orow + (size_t)(16 * ib) * 1024) = ow; }
    }
    __syncthreads();
}
#undef RET_TR
#undef RET_LW
#undef RET_MFMA
#undef RLAS
}


namespace tg {
using pg8::bf16_t; using pg8::bf16x8; using pg8::f32x4; using pg8::u32x4; using pg8::HTB; using pg8::lds_byte; using pg8::stage_rc; using pg8::perm32;
constexpr int STG = 3 * HTB;
template <bool PERM, int LDA, int LDB, bool ENTRY_SYNC = true>
__device__ __forceinline__ void accum(PG8_LAS unsigned char* lds, int tid_in, const bf16_t* A_in, const bf16_t* Bt_in, int nk, f32x4 (&acc)[2][4][2]) {
    int tid = tid_in; const bf16_t* A = A_in; const bf16_t* Bt = Bt_in; asm volatile("" : "+v"(tid), "+s"(A), "+s"(Bt));
    const int wid = __builtin_amdgcn_readfirstlane(tid >> 6), lane = tid & 63, wr = wid >> 2, wc = wid & 3, fr = lane & 15, fq = lane >> 4;
    unsigned voffA[2], voffB[2];
#pragma unroll
    for (int i = 0; i < 2; ++i) { int R, C; stage_rc(tid * 16 + i * 8192, R, C); const int Rb = PERM ? ((R & ~31) + perm32(R & 31)) : R;
        voffA[i] = (unsigned)(R * LDA + C) * 2u; voffB[i] = (unsigned)(Rb * LDB + C) * 2u; }
    const unsigned ldsw = (unsigned)wid * 1024u;
    const int aoff = lds_byte(wr * 64 + fr, fq * 8), boff = lds_byte(wc * 32 + fr, fq * 8);
    constexpr size_t hstepB = (size_t)128 * LDB * 2;
#define TG_STAGE(bufoff, gbase, voff) do { _Pragma("unroll") for (int _i = 0; _i < 2; ++_i) \
        __builtin_amdgcn_global_load_lds((const unsigned*)((const char*)(gbase) + (voff)[_i]), (PG8_LAS unsigned*)(lds + (bufoff) + ldsw + _i * 8192), 16, 0, 0); } while (0)
#define TG_STAGE_ALL(so, kt) do { const char* a_ = (const char*)A + (size_t)(kt) * 128; const char* b_ = (const char*)Bt + (size_t)(kt) * 128; \
        TG_STAGE((so), a_, voffA); TG_STAGE((so) + HTB, b_, voffB); TG_STAGE((so) + 2 * HTB, b_ + hstepB, voffB); } while (0)
#define TG_COMPUTE(so) do { bf16x8 At[4][2], B0[2][2], B1[2][2]; \
        _Pragma("unroll") for (int m = 0; m < 4; ++m) _Pragma("unroll") for (int k = 0; k < 2; ++k) At[m][k] = *(const PG8_LAS bf16x8*)(lds + (so) + aoff + m * 2048 + k * 1024); \
        _Pragma("unroll") for (int n = 0; n < 2; ++n) _Pragma("unroll") for (int k = 0; k < 2; ++k) { B0[n][k] = *(const PG8_LAS bf16x8*)(lds + (so) + HTB + boff + n * 2048 + k * 1024); \
                                                                                                   B1[n][k] = *(const PG8_LAS bf16x8*)(lds + (so) + 2 * HTB + boff + n * 2048 + k * 1024); } \
        __builtin_amdgcn_s_setprio(1); \
        _Pragma("unroll") for (int m = 0; m < 4; ++m) _Pragma("unroll") for (int n = 0; n < 2; ++n) _Pragma("unroll") for (int k = 0; k < 2; ++k) { \
            acc[0][m][n] = __builtin_amdgcn_mfma_f32_16x16x32_bf16(B0[n][k], At[m][k], acc[0][m][n], 0, 0, 0); \
            acc[1][m][n] = __builtin_amdgcn_mfma_f32_16x16x32_bf16(B1[n][k], At[m][k], acc[1][m][n], 0, 0, 0); } \
        __builtin_amdgcn_s_setprio(0); } while (0)
    if constexpr (ENTRY_SYNC) { asm volatile("s_waitcnt vmcnt(0)" ::: "memory"); __syncthreads(); }
    TG_STAGE_ALL(0, 0); TG_STAGE_ALL(STG, 1);
    int s0 = 0, s1 = STG, s2 = 2 * STG;
#pragma unroll 1
    for (int kt = 0; kt < nk; ++kt) {
        if (kt + 1 < nk) asm volatile("s_waitcnt vmcnt(6)" ::: "memory"); else asm volatile("s_waitcnt vmcnt(0)" ::: "memory");
        __builtin_amdgcn_s_barrier();
        asm volatile("" ::: "memory");
        if (kt + 2 < nk) TG_STAGE_ALL(s2, kt + 2);
        TG_COMPUTE(s0);
        const int t_ = s0; s0 = s1; s1 = s2; s2 = t_;
    }
#undef TG_STAGE
#undef TG_STAGE_ALL
#undef TG_COMPUTE
}
__device__ __forceinline__ void zero_acc(f32x4 (&acc)[2][4][2]) {
#pragma unroll
    for (int b = 0; b < 2; ++b)
#pragma unroll
        for (int m = 0; m < 4; ++m)
#pragma unroll
            for (int n = 0; n < 2; ++n) acc[b][m][n] = (f32x4){0.f, 0.f, 0.f, 0.f};
}
}

constexpr int NWAVES = 8;
constexpr int BATCH = 32, SEQ = 2048, DM = 1024, DEPTH = 4, INW = 11264;
constexpr int MTOK = BATCH * SEQ;
constexpr int NGRP = 2, MG = MTOK / NGRP;
constexpr float EPS = 1e-6f;
constexpr size_t MiB = 1u << 20;
constexpr size_t WS_CTL = 0, CTL_ZERO_BYTES = 1 * MiB;
constexpr size_t WS_MOD = 1 * MiB;
constexpr size_t WS_WIN = 4 * MiB;
constexpr size_t WS_WPA = 92 * MiB;
constexpr size_t WS_WPR = 96 * MiB;
constexpr size_t WS_WOUT = 104 * MiB;
constexpr size_t WS_LSE = 112 * MiB;
constexpr size_t WS_H = 116 * MiB, H_BYTES = 64 * MiB;
constexpr size_t WS_P = 244 * MiB;
constexpr size_t WS_END = WS_P + (size_t)MG * pg8::LDP * 2;
static_assert(WS_END <= 1024 * MiB, "workspace map");
constexpr int CW_BAR = 4096;
constexpr int RING_OFF = 0, RING_BYTES = 147456;
constexpr int SSQ_OFF = RING_BYTES, LDSCTL_OFF = SSQ_OFF + 4096, MISC_OFF = LDSCTL_OFF + 320;
constexpr int LDS_BYTES = 155648;

struct Args { const float* x; const float* c; const int* pos; const float* norm_w; const float* w_ada; const float* b_ada; const float* w_in; const float* gn_w;
              const float* w_pa; const float* w_pr; const float* w_out; const float* fnw; float* out; unsigned char* ws; int ph_lo, ph_hi, l_lo, l_hi, g_lo, g_hi; };
static_assert(sizeof(Args) == 14 * 8 + 6 * 4, "Args has no padding");

struct Frame {
    LAS unsigned char* lds;
    int tid, lane, wave, vcu, G, bx;
};
__device__ __forceinline__ Frame mkframe(int wave_id) {
    Frame F; extern __shared__ __attribute__((aligned(16))) unsigned char lds[];
    F.lds = (LAS unsigned char*)lds;
    unsigned z_ = 0u; asm volatile("" : "+v"(z_));
    const int ln = (int)__builtin_amdgcn_mbcnt_hi(~0u, __builtin_amdgcn_mbcnt_lo(~0u, z_));
    int bx = blockIdx.x, G = gridDim.x, wv = wave_id; asm volatile("" : "+s"(bx), "+s"(G), "+s"(wv));
    F.lane = ln; F.wave = wv; F.tid = wv * 64 + ln; F.G = G; F.bx = bx;
    F.vcu = (G % 8 == 0) ? (bx % 8) * (G / 8) + bx / 8 : bx;
    return F;
}
__device__ __forceinline__ float shx(int lane, float v, int m) { return __uint_as_float((unsigned)__builtin_amdgcn_ds_bpermute((lane ^ m) << 2, (int)__float_as_uint(v))); }
typedef const __attribute__((address_space(4))) Args* KArgs;
__device__ __forceinline__ KArgs kargs() { KArgs p = (KArgs)__builtin_amdgcn_kernarg_segment_ptr(); asm volatile("" : "+s"(p)); return p; }

__device__ __forceinline__ float wave_sum(int lane, float v) {
#pragma unroll
    for (int o = 1; o < 64; o <<= 1) v += shx(lane, v, o);
    return v;
}
__device__ __forceinline__ float blo(unsigned w) { return __uint_as_float(w << 16); }
__device__ __forceinline__ float bhi(unsigned w) { return __uint_as_float(w & 0xffff0000u); }
__device__ __forceinline__ float silu_f(float x) { return x / (1.0f + __expf(-x)); }

__device__ __forceinline__ void p0_transpose_item(const float* W, int K, int N, bf16* WT, LAS float* scr, int item, int lane) {
    const int nblk = N / 32, kb = item / nblk, nb = item % nblk, k0 = 64 * kb, n0 = 32 * nb;
#pragma unroll 8
    for (int i = 0; i < 32; ++i) { const int kk = 2 * i + (lane >> 5); scr[kk * 33 + (lane & 31)] = W[(size_t)(k0 + kk) * N + n0 + (lane & 31)]; }
    LDS_WAIT(); asm volatile("" ::: "memory");
    const int c = lane & 7;
#pragma unroll
    for (int j = 0; j < 4; ++j) { const int n = (lane >> 3) + 8 * j; const LAS float* s = scr + (8 * c) * 33 + n;
        v4u o; o.x = pk2(s[0 * 33], s[1 * 33]); o.y = pk2(s[2 * 33], s[3 * 33]); o.z = pk2(s[4 * 33], s[5 * 33]); o.w = pk2(s[6 * 33], s[7 * 33]);
        *(GAS v4u*)(WT + (size_t)(n0 + n) * K + k0 + 8 * c) = o; }
    LDS_WAIT(); asm volatile("" ::: "memory");
}
__device__ __forceinline__ void p0_mod_item(Frame& F, const float* cin, const float* w_ada, const float* b_ada, float* MOD, int item) {
    const int l = item / 48, n0 = (item % 48) * 64;
    LAS float* cact = (LAS float*)(F.lds + RING_OFF);
    for (int i = F.tid; i < BATCH * DM; i += NWAVES * 64) cact[i] = silu_f(cin[i]);
    LDS_WAIT(); __syncthreads();
    float acc[BATCH];
#pragma unroll
    for (int b = 0; b < BATCH; ++b) acc[b] = 0.f;
    const float* wp = w_ada + ((size_t)l * DM + F.wave * 128) * 3072 + n0 + F.lane;
    for (int k4 = 0; k4 < 32; ++k4) {
        const float w0 = wp[(size_t)(4 * k4 + 0) * 3072], w1 = wp[(size_t)(4 * k4 + 1) * 3072], w2 = wp[(size_t)(4 * k4 + 2) * 3072], w3 = wp[(size_t)(4 * k4 + 3) * 3072];
#pragma unroll
        for (int b = 0; b < BATCH; ++b) { const f32x4 cv = *(const LAS f32x4*)(cact + b * DM + F.wave * 128 + 4 * k4);
            acc[b] += cv.x * w0 + cv.y * w1 + cv.z * w2 + cv.w * w3; }
    }
    __syncthreads();
    LAS float* part = (LAS float*)(F.lds + RING_OFF);
#pragma unroll
    for (int b = 0; b < BATCH; ++b) part[(F.wave * BATCH + b) * 64 + F.lane] = acc[b];
    LDS_WAIT(); __syncthreads();
    for (int o = F.tid; o < BATCH * 64; o += NWAVES * 64) { const int b = o >> 6, cn = o & 63; float s = 0.f;
#pragma unroll
        for (int w = 0; w < NWAVES; ++w) s += part[(w * BATCH + b) * 64 + cn];
        MOD[((size_t)l * BATCH + b) * 3072 + n0 + cn] = s + b_ada[l * 3072 + n0 + cn]; }
    LDS_WAIT(); __syncthreads();
}
__device__ __forceinline__ void p0_prologue(Frame& F, KArgs a, unsigned char* ws) {
    if (F.bx < DEPTH * 48) p0_mod_item(F, a->c, a->w_ada, a->b_ada, (float*)(ws + WS_MOD), F.bx);
    LAS float* scr = (LAS float*)(F.lds + RING_OFF + F.wave * 16384);
    const int gw = F.vcu * NWAVES + F.wave, NGW = F.G * NWAVES;
    constexpr int I_IN = (DM / 64) * (INW / 32), I_PA = (512 / 64) * (DM / 32), I_PR = (DM / 64) * (DM / 32), I_L = I_IN + I_PA + 2 * I_PR;
    const float* w_in = a->w_in; const float* w_pa = a->w_pa; const float* w_pr = a->w_pr; const float* w_out = a->w_out;
    bf16* Win = (bf16*)(ws + WS_WIN); bf16* Wpa = (bf16*)(ws + WS_WPA); bf16* Wpr = (bf16*)(ws + WS_WPR); bf16* Wout = (bf16*)(ws + WS_WOUT);
    for (int it = gw; it < DEPTH * I_L; it += NGW) {
        const int l = it / I_L; int r = it % I_L;
        if (r < I_IN) { p0_transpose_item(w_in + (size_t)l * DM * INW, DM, INW, Win + (size_t)l * INW * DM, scr, r, F.lane); continue; } r -= I_IN;
        if (r < I_PA) { p0_transpose_item(w_pa + (size_t)l * 512 * DM, 512, DM, Wpa + (size_t)l * DM * 512, scr, r, F.lane); continue; } r -= I_PA;
        if (r < I_PR) { p0_transpose_item(w_pr + (size_t)l * DM * DM, DM, DM, Wpr + (size_t)l * DM * DM, scr, r, F.lane); continue; } r -= I_PR;
        p0_transpose_item(w_out + (size_t)l * DM * DM, DM, DM, Wout + (size_t)l * DM * DM, scr, r, F.lane);
    }
}
__device__ __forceinline__ void norm_phase(Frame& F, const float* xs, const float* nw, const float* MODl, bf16* H, int tok0) {
    const int gw = F.vcu * NWAVES + F.wave, NGW = F.G * NWAVES;
    for (int m = gw; m < MG; m += NGW) {
        const int tok = tok0 + m, b = tok >> 11;
        const float* mod = MODl + (size_t)b * 3072;
        const GAS f32x4* xr = (const GAS f32x4*)(xs + (size_t)tok * DM) + F.lane;
        f32x4 v[4]; float s = 0.f;
#pragma unroll
        for (int j = 0; j < 4; ++j) { v[j] = xr[64 * j]; s += (v[j].x * v[j].x + v[j].y * v[j].y) + (v[j].z * v[j].z + v[j].w * v[j].w); }
        const float rstd = 1.0f / sqrtf(wave_sum(F.lane, s) * (1.f / DM) + EPS);
        GAS unsigned long long* o8 = (GAS unsigned long long*)(H + (size_t)m * DM) + F.lane;
#pragma unroll
        for (int j = 0; j < 4; ++j) { const int c = 4 * F.lane + 256 * j;
            const f32x4 w = *(const f32x4*)(nw + c), sh = *(const f32x4*)(mod + c), sc = *(const f32x4*)(mod + 1024 + c);
            const f32x4 y = v[j] * rstd * w * (sc + 1.0f) + sh;
            o8[64 * j] = (unsigned long long)pk2(y.x, y.y) | ((unsigned long long)pk2(y.z, y.w) << 32); }
    }
}
__device__ __forceinline__ void final_norm_phase(Frame& F, float* out, const float* fnw) {
    const int gw = F.vcu * NWAVES + F.wave, NGW = F.G * NWAVES;
    for (int m = gw; m < MTOK; m += NGW) {
        GAS f32x4* xr = (GAS f32x4*)(out + (size_t)m * DM) + F.lane;
        f32x4 v[4]; float s = 0.f;
#pragma unroll
        for (int j = 0; j < 4; ++j) { v[j] = xr[64 * j]; s += (v[j].x * v[j].x + v[j].y * v[j].y) + (v[j].z * v[j].z + v[j].w * v[j].w); }
        const float rstd = 1.0f / sqrtf(wave_sum(F.lane, s) * (1.f / DM) + EPS);
#pragma unroll
        for (int j = 0; j < 4; ++j) { const f32x4 w = *(const f32x4*)(fnw + 4 * F.lane + 256 * j); xr[64 * j] = v[j] * rstd * w; }
    }
}
__device__ __forceinline__ void attn_naive_phase(Frame& F, bf16* P, float* LSE) {
    const int gtid = F.vcu * (NWAVES * 64) + F.tid, NT = F.G * NWAVES * 64;
    for (int it2 = gtid; it2 < 2 * 12 * MG; it2 += NT) {
        const int item = it2 >> 1, half = it2 & 1;
        const int hg = item / MG, n = item % MG, gi = hg >> 2, dsh = 2 * gi, Lsub = SEQ >> dsh;
        const int b = n >> 11, rem = n & 2047, r = rem >> (11 - dsh), m = rem & (Lsub - 1);
        const int row = b * SEQ + (m << dsh) + r;
        bf16* qp = P + (size_t)row * pg8::LDP + pg8::C_QA + hg * 128 + half * 64;
        v4u q[8];
#pragma unroll
        for (int i = 0; i < 8; ++i) q[i] = *(const GAS v4u*)(qp + 8 * i);
        float o[64];
#pragma unroll
        for (int i = 0; i < 64; ++i) o[i] = 0.f;
        float mrun = -1e30f, lsum = 0.f;
        const int mlo = m > 128 ? m - 128 : 0;
        for (int mk = mlo; mk <= m; ++mk) {
            const bf16* kp = P + (size_t)(b * SEQ + (mk << dsh) + r) * pg8::LDP + pg8::C_KA + hg * 128 + half * 64;
            float d0 = 0.f, d1 = 0.f;
#pragma unroll
            for (int i = 0; i < 8; ++i) { const v4u kv = *(const GAS v4u*)(kp + 8 * i);
                d0 += blo(q[i].x) * blo(kv.x) + blo(q[i].y) * blo(kv.y) + blo(q[i].z) * blo(kv.z) + blo(q[i].w) * blo(kv.w);
                d1 += bhi(q[i].x) * bhi(kv.x) + bhi(q[i].y) * bhi(kv.y) + bhi(q[i].z) * bhi(kv.z) + bhi(q[i].w) * bhi(kv.w); }
            float dt = d0 + d1; dt += shx(F.lane, dt, 1);
            const float sc = dt * 0.08838834764831845f;
            const float mn = fmaxf(mrun, sc), al = __expf(mrun - mn), p = __expf(sc - mn);
            lsum = lsum * al + p; mrun = mn;
            const bf16* vp = kp + (pg8::C_VA - pg8::C_KA);
#pragma unroll
            for (int i = 0; i < 8; ++i) { const v4u vv = *(const GAS v4u*)(vp + 8 * i);
                o[8 * i + 0] = o[8 * i + 0] * al + p * blo(vv.x); o[8 * i + 1] = o[8 * i + 1] * al + p * bhi(vv.x);
                o[8 * i + 2] = o[8 * i + 2] * al + p * blo(vv.y); o[8 * i + 3] = o[8 * i + 3] * al + p * bhi(vv.y);
                o[8 * i + 4] = o[8 * i + 4] * al + p * blo(vv.z); o[8 * i + 5] = o[8 * i + 5] * al + p * bhi(vv.z);
                o[8 * i + 6] = o[8 * i + 6] * al + p * blo(vv.w); o[8 * i + 7] = o[8 * i + 7] * al + p * bhi(vv.w); }
        }
        const float inv = 1.0f / lsum;
#pragma unroll
        for (int i = 0; i < 8; ++i) { v4u w; w.x = pk2(o[8 * i] * inv, o[8 * i + 1] * inv); w.y = pk2(o[8 * i + 2] * inv, o[8 * i + 3] * inv);
            w.z = pk2(o[8 * i + 4] * inv, o[8 * i + 5] * inv); w.w = pk2(o[8 * i + 6] * inv, o[8 * i + 7] * inv); *(GAS v4u*)(qp + 8 * i) = w; }
        if (half == 0) LSE[(size_t)row * 12 + hg] = mrun + __logf(lsum);
    }
}
__device__ __forceinline__ att::BlockRef attn_ref(int L, bf16* P, float* LSE) {
    const int blk = L / 192, rem = L - blk * 192, b = rem / 12, hg = rem - b * 12, g = hg >> 2;
    att::BlockRef r; int r0;
    if (g == 0) { r0 = 0; r.P0 = blk * 256; r.dsh = 0; r.lmask = 0x7fffffff; r.lsh = 31; r.g2 = 0; }
    else if (g == 1) { r0 = blk >> 1; r.P0 = (blk & 1) * 256; r.dsh = 2; r.lmask = 0x7fffffff; r.lsh = 31; r.g2 = 0; }
    else { r0 = 2 * blk; r.P0 = 0; r.dsh = 4; r.lmask = 127; r.lsh = 7; r.g2 = 1; }
    const size_t rowbase = (size_t)b * SEQ + r0;
    bf16* q = P + rowbase * pg8::LDP + pg8::C_QA + hg * 128;
    r.Q = q; r.L = LSE + rowbase * 12 + hg;
    return r;
}
__device__ __forceinline__ void attn_phase(Frame& F, bf16* P, float* LSE, int L0, int step, int cnt, bool dry = false) {
    if (cnt <= 0) return;
    char* lds = (char*)F.lds + RING_OFF;
    int L = L0, k = 0;
    att::BlockRef cur = attn_ref(L, P, LSE); att::Seam S;
    att::swa_prime(cur, lds, S, F.tid);
    for (;;) {
        const bool last = (k + 1 >= cnt);
        const att::BlockRef nxt = last ? cur : attn_ref(L + step, P, LSE);
        att::swa_block(cur, nxt, lds, S, F.tid, dry);
        if (last) break;
        cur = nxt; L += step; ++k;
    }
}
__device__ __forceinline__ void mix_phase(Frame& F, bf16* P, bf16* H, float* LSE) {
    constexpr int NRU = (MG / SEQ) * 4 * 2, NAB = 12 * (MG / SEQ) * 8;
    static_assert(NRU == 128 && NAB == 12 * 128, "mixer dealing is written for a 256-workgroup grid");
    if (F.G != 256) {
#if !RET_NAIVE
        for (int u = F.bx; u < NRU; u += F.G) { const int b = u >> 3, h = (u >> 1) & 3, eh = u & 1;
            ret::ret_unit(F.lds + RING_OFF, F.tid, P + (size_t)b * SEQ * pg8::LDP + pg8::C_QR + h * 256, H + (size_t)b * SEQ * DM + h * 256 + eh * 128, eh, h); }
#endif
        attn_phase(F, P, LSE, F.bx, F.G, (NAB - F.bx + F.G - 1) / F.G);
        return;
    }
    const bool isret = (F.vcu & 3) < 2;
    const int u = (F.vcu >> 2) * 2 + (F.vcu & 1);
#if !RET_NAIVE
#if PROBE_SEL == 30
    if (F.wave == 0) ((volatile LAS unsigned long long*)(F.lds + MISC_OFF + 64))[0] = __builtin_amdgcn_s_memrealtime();
#endif
    if (isret) { const int b = u >> 3, h = (u >> 1) & 3, eh = u & 1;
        ret::ret_unit(F.lds + RING_OFF, F.tid, P + (size_t)b * SEQ * pg8::LDP + pg8::C_QR + h * 256, H + (size_t)b * SEQ * DM + h * 256 + eh * 128, eh, h); }
#if PROBE_SEL == 30
    if (F.wave == 0) { volatile LAS unsigned long long* p_ = (volatile LAS unsigned long long*)(F.lds + MISC_OFF + 64); const unsigned long long v_ = p_[1] + (__builtin_amdgcn_s_memrealtime() - p_[0]); p_[1] = v_; }
#endif
#endif
#if DUP_RET
    if (isret) { const int b = u >> 3, h = (u >> 1) & 3, eh = u & 1;
        ret::ret_unit(F.lds + RING_OFF, F.tid, P + (size_t)b * SEQ * pg8::LDP + pg8::C_QR + h * 256, H + (size_t)b * SEQ * DM + h * 256 + eh * 128, eh, h); }
#endif
#if DUP_ATT
    { int dflag = 1; asm volatile("" : "+s"(dflag)); if (!isret) attn_phase(F, P, LSE, u, 128, 12, dflag != 0); }
#endif
    if (!isret) attn_phase(F, P, LSE, u, 128, 12);
}
__device__ __forceinline__ void ret_naive_phase(Frame& F, const bf16* P, bf16* H) {
    const int gtid = F.vcu * (NWAVES * 64) + F.tid, NT = F.G * NWAVES * 64;
    for (int it4 = gtid; it4 < 4 * 4 * MG; it4 += NT) {
        const int it0 = __builtin_amdgcn_readfirstlane(it4) >> 2;
        const int h = it0 / MG, n0 = it0 % MG, b = n0 >> 11, s0 = n0 & 2047, s = s0 + (F.lane >> 2), qd = F.lane & 3;
        const int row = b * SEQ + s;
        const float lg = __builtin_log2f(1.0f - __builtin_amdgcn_exp2f(-5.0f - (float)h));
        const bf16* qp = P + (size_t)row * pg8::LDP + pg8::C_QR + h * 256 + qd * 64;
        v4u q[8];
#pragma unroll
        for (int i = 0; i < 8; ++i) q[i] = *(const GAS v4u*)(qp + 8 * i);
        float o[64];
#pragma unroll
        for (int i = 0; i < 64; ++i) o[i] = 0.f;
        const int ci = s >> 7;
        for (int j = 0; j <= s0 + 15; ++j) {
            const bf16* kp = P + (size_t)(b * SEQ + j) * pg8::LDP + pg8::C_KR + h * 256 + qd * 64;
            float d0 = 0.f, d1 = 0.f;
#pragma unroll
            for (int i = 0; i < 8; ++i) { const v4u kv = *(const GAS v4u*)(kp + 8 * i);
                d0 += blo(q[i].x) * blo(kv.x) + blo(q[i].y) * blo(kv.y) + blo(q[i].z) * blo(kv.z) + blo(q[i].w) * blo(kv.w);
                d1 += bhi(q[i].x) * bhi(kv.x) + bhi(q[i].y) * bhi(kv.y) + bhi(q[i].z) * bhi(kv.z) + bhi(q[i].w) * bhi(kv.w); }
            float dt = d0 + d1; dt += shx(F.lane, dt, 1); dt += shx(F.lane, dt, 2);
            float w = dt * __builtin_amdgcn_exp2f((float)(128 * (ci - (j >> 7))) * lg);
            if (j > s) w = 0.f;
            const bf16* vp = kp + (pg8::C_VR - pg8::C_KR);
#pragma unroll
            for (int i = 0; i < 8; ++i) { const v4u vv = *(const GAS v4u*)(vp + 8 * i);
                o[8 * i + 0] += w * blo(vv.x); o[8 * i + 1] += w * bhi(vv.x); o[8 * i + 2] += w * blo(vv.y); o[8 * i + 3] += w * bhi(vv.y);
                o[8 * i + 4] += w * blo(vv.z); o[8 * i + 5] += w * bhi(vv.z); o[8 * i + 6] += w * blo(vv.w); o[8 * i + 7] += w * bhi(vv.w); }
        }
        bf16* op = H + (size_t)row * DM + h * 256 + qd * 64;
#pragma unroll
        for (int i = 0; i < 8; ++i) { v4u w; w.x = pk2(o[8 * i], o[8 * i + 1]); w.y = pk2(o[8 * i + 2], o[8 * i + 3]); w.z = pk2(o[8 * i + 4], o[8 * i + 5]); w.w = pk2(o[8 * i + 6], o[8 * i + 7]);
            *(GAS v4u*)(op + 8 * i) = w; }
    }
}
__device__ __forceinline__ void combine_phase(Frame& F, bf16* P, const bf16* H, const float* LSE, const float* gnw) {
    const int gw = F.vcu * NWAVES + F.wave, NGW = F.G * NWAVES, L = F.lane;
    for (int m = gw; m < MG; m += NGW) {
        bf16* pr = P + (size_t)m * pg8::LDP;
        {
            const int j = L >> 4, c0 = 8 * L, d0 = c0 & 127;
            const float l0 = LSE[(size_t)m * 12 + j], l1 = LSE[(size_t)m * 12 + 4 + j], l2 = LSE[(size_t)m * 12 + 8 + j];
            const float mx = fmaxf(l0, fmaxf(l1, l2));
            float e0 = __expf(l0 - mx), e1 = __expf(l1 - mx), e2 = __expf(l2 - mx);
            const float inv = 1.0f / (e0 + e1 + e2); e0 *= inv; e1 *= inv; e2 *= inv;
            const v4u a0 = *(const GAS v4u*)(pr + pg8::C_QA + (0 + j) * 128 + d0), a1 = *(const GAS v4u*)(pr + pg8::C_QA + (4 + j) * 128 + d0), a2 = *(const GAS v4u*)(pr + pg8::C_QA + (8 + j) * 128 + d0);
            const v4u z = *(const GAS v4u*)(pr + pg8::C_ZA + c0);
            v4u w;
#define CMB2(f) pk2((e0 * blo(a0.f) + e1 * blo(a1.f) + e2 * blo(a2.f)) * blo(z.f), (e0 * bhi(a0.f) + e1 * bhi(a1.f) + e2 * bhi(a2.f)) * bhi(z.f))
            w.x = CMB2(x); w.y = CMB2(y); w.z = CMB2(z); w.w = CMB2(w);
#undef CMB2
            *(GAS v4u*)(pr + pg8::C_ZA + c0) = w;
        }
        {
            const int c0 = 16 * L;
            const v4u u0 = *(const GAS v4u*)(H + (size_t)m * DM + c0), u1 = *(const GAS v4u*)(H + (size_t)m * DM + c0 + 8);
            float v[16] = {blo(u0.x), bhi(u0.x), blo(u0.y), bhi(u0.y), blo(u0.z), bhi(u0.z), blo(u0.w), bhi(u0.w), blo(u1.x), bhi(u1.x), blo(u1.y), bhi(u1.y), blo(u1.z), bhi(u1.z), blo(u1.w), bhi(u1.w)};
            float s = 0.f;
#pragma unroll
            for (int i = 0; i < 16; ++i) s += v[i];
            s += shx(L, s, 1); s += shx(L, s, 2); s += shx(L, s, 4); s += shx(L, s, 8);
            const float mu = s * (1.0f / 256.0f); float q = 0.f;
#pragma unroll
            for (int i = 0; i < 16; ++i) { v[i] -= mu; q += v[i] * v[i]; }
            q += shx(L, q, 1); q += shx(L, q, 2); q += shx(L, q, 4); q += shx(L, q, 8);
            const float rstd = 1.0f / sqrtf(q * (1.0f / 256.0f) + EPS);
            const v4u z0 = *(const GAS v4u*)(pr + pg8::C_ZR + c0), z1 = *(const GAS v4u*)(pr + pg8::C_ZR + c0 + 8);
            const float zz[16] = {blo(z0.x), bhi(z0.x), blo(z0.y), bhi(z0.y), blo(z0.z), bhi(z0.z), blo(z0.w), bhi(z0.w), blo(z1.x), bhi(z1.x), blo(z1.y), bhi(z1.y), blo(z1.z), bhi(z1.z), blo(z1.w), bhi(z1.w)};
            float y[16];
#pragma unroll
            for (int i = 0; i < 4; ++i) { const f32x4 g = *(const f32x4*)(gnw + c0 + 4 * i);
                y[4 * i] = v[4 * i] * rstd * g.x * zz[4 * i]; y[4 * i + 1] = v[4 * i + 1] * rstd * g.y * zz[4 * i + 1]; y[4 * i + 2] = v[4 * i + 2] * rstd * g.z * zz[4 * i + 2]; y[4 * i + 3] = v[4 * i + 3] * rstd * g.w * zz[4 * i + 3]; }
            v4u w0, w1; w0.x = pk2(y[0], y[1]); w0.y = pk2(y[2], y[3]); w0.z = pk2(y[4], y[5]); w0.w = pk2(y[6], y[7]); w1.x = pk2(y[8], y[9]); w1.y = pk2(y[10], y[11]); w1.z = pk2(y[12], y[13]); w1.w = pk2(y[14], y[15]);
            *(GAS v4u*)(pr + pg8::C_ZR + c0) = w0; *(GAS v4u*)(pr + pg8::C_ZR + c0 + 8) = w1;
        }
    }
}

__device__ __forceinline__ void wg_rewrite_fence() {
    asm volatile("s_waitcnt vmcnt(0) lgkmcnt(0)" ::: "memory"); __syncthreads();
}
__device__ __forceinline__ void combine_rows(Frame& F, bf16* P, const bf16* H, const float* LSE, const float* gnw, int r0, int nrows, int wave_lin, int nwaves) {
    const int L = F.lane;
    constexpr int R = 4;
    {
        const int j = L >> 4, c0 = 8 * L, d0 = c0 & 127;
        for (int m0 = r0 + R * wave_lin; m0 < r0 + nrows; m0 += R * nwaves) {
            v4u a0[R], a1[R], a2[R], z[R]; float l0[R], l1[R], l2[R];
#pragma unroll
            for (int i = 0; i < R; ++i) { const bf16* pr = P + (size_t)(m0 + i) * pg8::LDP; const float* ls = LSE + (size_t)(m0 + i) * 12 + j;
                l0[i] = ls[0]; l1[i] = ls[4]; l2[i] = ls[8];
                a0[i] = *(const GAS v4u*)(pr + pg8::C_QA + (0 + j) * 128 + d0); a1[i] = *(const GAS v4u*)(pr + pg8::C_QA + (4 + j) * 128 + d0); a2[i] = *(const GAS v4u*)(pr + pg8::C_QA + (8 + j) * 128 + d0);
                z[i] = *(const GAS v4u*)(pr + pg8::C_ZA + c0); }
#pragma unroll
            for (int i = 0; i < R; ++i) {
                const float mx = fmaxf(l0[i], fmaxf(l1[i], l2[i]));
                float e0 = __expf(l0[i] - mx), e1 = __expf(l1[i] - mx), e2 = __expf(l2[i] - mx);
                const float inv = 1.0f / (e0 + e1 + e2); e0 *= inv; e1 *= inv; e2 *= inv;
                v4u w;
#define CMB2(f) pk2((e0 * blo(a0[i].f) + e1 * blo(a1[i].f) + e2 * blo(a2[i].f)) * blo(z[i].f), (e0 * bhi(a0[i].f) + e1 * bhi(a1[i].f) + e2 * bhi(a2[i].f)) * bhi(z[i].f))
                w.x = CMB2(x); w.y = CMB2(y); w.z = CMB2(z); w.w = CMB2(w);
#undef CMB2
                *(GAS v4u*)(P + (size_t)(m0 + i) * pg8::LDP + pg8::C_ZA + c0) = w; }
        }
    }
    {
        const int c0 = 16 * L;
        f32x4 g[4];
#pragma unroll
        for (int i = 0; i < 4; ++i) g[i] = *(const f32x4*)(gnw + c0 + 4 * i);
        for (int m0 = r0 + R * wave_lin; m0 < r0 + nrows; m0 += R * nwaves) {
            v4u u0[R], u1[R], z0[R], z1[R];
#pragma unroll
            for (int i = 0; i < R; ++i) { const bf16* pr = P + (size_t)(m0 + i) * pg8::LDP; const bf16* hr = H + (size_t)(m0 + i) * DM + c0;
                u0[i] = *(const GAS v4u*)(hr); u1[i] = *(const GAS v4u*)(hr + 8); z0[i] = *(const GAS v4u*)(pr + pg8::C_ZR + c0); z1[i] = *(const GAS v4u*)(pr + pg8::C_ZR + c0 + 8); }
#pragma unroll
            for (int i = 0; i < R; ++i) {
                float v[16] = {blo(u0[i].x), bhi(u0[i].x), blo(u0[i].y), bhi(u0[i].y), blo(u0[i].z), bhi(u0[i].z), blo(u0[i].w), bhi(u0[i].w), blo(u1[i].x), bhi(u1[i].x), blo(u1[i].y), bhi(u1[i].y), blo(u1[i].z), bhi(u1[i].z), blo(u1[i].w), bhi(u1[i].w)};
                float sm = 0.f;
#pragma unroll
                for (int k = 0; k < 16; ++k) sm += v[k];
                sm += shx(L, sm, 1); sm += shx(L, sm, 2); sm += shx(L, sm, 4); sm += shx(L, sm, 8);
                const float mu = sm * (1.0f / 256.0f); float q = 0.f;
#pragma unroll
                for (int k = 0; k < 16; ++k) { v[k] -= mu; q += v[k] * v[k]; }
                q += shx(L, q, 1); q += shx(L, q, 2); q += shx(L, q, 4); q += shx(L, q, 8);
                const float rstd = 1.0f / sqrtf(q * (1.0f / 256.0f) + EPS);
                const float zz[16] = {blo(z0[i].x), bhi(z0[i].x), blo(z0[i].y), bhi(z0[i].y), blo(z0[i].z), bhi(z0[i].z), blo(z0[i].w), bhi(z0[i].w), blo(z1[i].x), bhi(z1[i].x), blo(z1[i].y), bhi(z1[i].y), blo(z1[i].z), bhi(z1[i].z), blo(z1[i].w), bhi(z1[i].w)};
                float y[16];
#pragma unroll
                for (int k = 0; k < 4; ++k) { y[4 * k] = v[4 * k] * rstd * g[k].x * zz[4 * k]; y[4 * k + 1] = v[4 * k + 1] * rstd * g[k].y * zz[4 * k + 1]; y[4 * k + 2] = v[4 * k + 2] * rstd * g[k].z * zz[4 * k + 2]; y[4 * k + 3] = v[4 * k + 3] * rstd * g[k].w * zz[4 * k + 3]; }
                v4u w0, w1; w0.x = pk2(y[0], y[1]); w0.y = pk2(y[2], y[3]); w0.z = pk2(y[4], y[5]); w0.w = pk2(y[6], y[7]); w1.x = pk2(y[8], y[9]); w1.y = pk2(y[10], y[11]); w1.z = pk2(y[12], y[13]); w1.w = pk2(y[14], y[15]);
                bf16* pr = P + (size_t)(m0 + i) * pg8::LDP;
                *(GAS v4u*)(pr + pg8::C_ZR + c0) = w0; *(GAS v4u*)(pr + pg8::C_ZR + c0 + 8) = w1; }
        }
    }
}
#if PROBE_SEL >= 10
#define TP_START() do { if (wid == 0) ((volatile LAS unsigned long long*)(F.lds + MISC_OFF + 64))[0] = __builtin_amdgcn_s_memrealtime(); } while (0)
#define TP_END(k) do { if ((k) == PROBE_SEL && wid == 0) { volatile LAS unsigned long long* p_ = (volatile LAS unsigned long long*)(F.lds + MISC_OFF + 64); const unsigned long long v_ = p_[1] + (__builtin_amdgcn_s_memrealtime() - p_[0]); p_[1] = v_; } } while (0)
#else
#define TP_START() do { } while (0)
#define TP_END(k) do { } while (0)
#endif
__device__ __forceinline__ void tail_phase(Frame& F, bf16* P, bf16* H, const float* LSE, const float* gnw, const bf16* Wpa, const bf16* Wpr, const bf16* Wout,
                                           const float* xin, float* xout, const float* MODl  , const float* MODn  ,
                                           const float* nwn  , int tok0, bool last) {
    using pg8::f32x4; using pg8::u32x4; using pg8::LDP;
    LAS float* ssq = (LAS float*)(F.lds + SSQ_OFF);
    for (int pnl = F.bx; pnl < MG / 128; pnl += F.G) {
        int lane_ = F.lane; asm volatile("" : "+v"(lane_));
        const int lane = lane_, wid = F.wave, tid = wid * 64 + lane, wr = wid >> 2, wc = wid & 3, fr = lane & 15, fq = lane >> 4;
        const int r0 = pnl * 128, b = (tok0 + r0) >> 11;
        TP_START();
        { Frame F2 = F; F2.lane = lane; F2.tid = tid; combine_rows(F2, P, H, LSE, gnw, r0, 128, wid, NWAVES); }
        wg_rewrite_fence();
        TP_END(10); TP_START();
#pragma unroll 1
        for (int pn = 0; pn < 4; ++pn) {
            f32x4 aa[2][4][2], ar[2][4][2]; tg::zero_acc(aa); tg::zero_acc(ar);
            tg::accum<true, LDP, 512>(F.lds + RING_OFF, tid, P + (size_t)r0 * LDP + pg8::C_ZA, Wpa + (size_t)pn * 256 * 512, 8, aa);
#if DUP_TG
            { f32x4 dm[2][4][2]; tg::zero_acc(dm);
              tg::accum<true, LDP, DM>(F.lds + RING_OFF, tid, P + (size_t)r0 * LDP + pg8::C_ZR, Wpr + (size_t)pn * 256 * DM, 16, dm);
              int fl = 0; asm volatile("" : "+s"(fl));
              if (fl) {
#pragma unroll
                  for (int m = 0; m < 4; ++m) { *(f32x4*)(xout + (size_t)(m * 64 + lane) * 4) = dm[0][m][0] + dm[0][m][1] + dm[1][m][0] + dm[1][m][1]; } } }
#endif
            tg::accum<true, LDP, DM>(F.lds + RING_OFF, tid, P + (size_t)r0 * LDP + pg8::C_ZR, Wpr + (size_t)pn * 256 * DM, 16, ar);
            const int col0 = pn * 256 + wc * 32 + 8 * fq;
            u32x4 gg[4][2], rg[4][2];
#pragma unroll
            for (int m = 0; m < 4; ++m) { const bf16* rowp = P + (size_t)(r0 + wr * 64 + m * 16 + fr) * LDP + col0;
#pragma unroll
                for (int bj = 0; bj < 2; ++bj) { gg[m][bj] = *(const u32x4*)(rowp + pg8::C_GA + bj * 128); rg[m][bj] = *(const u32x4*)(rowp + pg8::C_GR + bj * 128); } }
#pragma unroll
            for (int m = 0; m < 4; ++m) { bf16* rowp = P + (size_t)(r0 + wr * 64 + m * 16 + fr) * LDP + col0;
#pragma unroll
                for (int bj = 0; bj < 2; ++bj) { const u32x4 g = gg[m][bj], r = rg[m][bj];
                    const f32x4 a0 = aa[bj][m][0], a1 = aa[bj][m][1], c0 = ar[bj][m][0], c1 = ar[bj][m][1];
                    u32x4 w;
                    w.x = pg8::cvt_pk_bf16(pg8::bf_lo(g.x) * a0[0] + pg8::bf_lo(r.x) * c0[0], pg8::bf_hi(g.x) * a0[1] + pg8::bf_hi(r.x) * c0[1]);
                    w.y = pg8::cvt_pk_bf16(pg8::bf_lo(g.y) * a0[2] + pg8::bf_lo(r.y) * c0[2], pg8::bf_hi(g.y) * a0[3] + pg8::bf_hi(r.y) * c0[3]);
                    w.z = pg8::cvt_pk_bf16(pg8::bf_lo(g.z) * a1[0] + pg8::bf_lo(r.z) * c1[0], pg8::bf_hi(g.z) * a1[1] + pg8::bf_hi(r.z) * c1[1]);
                    w.w = pg8::cvt_pk_bf16(pg8::bf_lo(g.w) * a1[2] + pg8::bf_lo(r.w) * c1[2], pg8::bf_hi(g.w) * a1[3] + pg8::bf_hi(r.w) * c1[3]);
                    *(u32x4*)(rowp + pg8::C_GA + bj * 128) = w; } }
        }
        wg_rewrite_fence();
        TP_END(11); TP_START();
        float ss[4] = {0.f, 0.f, 0.f, 0.f};
#pragma unroll 1
        for (int pn = 0; pn < 4; ++pn) {
            f32x4 ac[2][4][2]; tg::zero_acc(ac);
            const int col0 = pn * 256 + wc * 32 + 4 * fq;
            asm volatile("s_waitcnt vmcnt(0)" ::: "memory"); __syncthreads();
            f32x4 xv[4][2][2];
#pragma unroll
            for (int m = 0; m < 4; ++m) { const size_t off = (size_t)(tok0 + r0 + wr * 64 + m * 16 + fr) * DM + col0;
#pragma unroll
                for (int bj = 0; bj < 2; ++bj)
#pragma unroll
                    for (int n = 0; n < 2; ++n) xv[m][bj][n] = *(const f32x4*)(xin + off + bj * 128 + n * 16); }
            asm volatile("" ::: "memory");
            tg::accum<false, LDP, DM, false>(F.lds + RING_OFF, tid, P + (size_t)r0 * LDP + pg8::C_GA, Wout + (size_t)pn * 256 * DM, 16, ac);
            f32x4 gv[2][2];
#pragma unroll
            for (int bj = 0; bj < 2; ++bj)
#pragma unroll
                for (int n = 0; n < 2; ++n) gv[bj][n] = *(const f32x4*)(MODl + (size_t)b * 3072 + 2048 + col0 + bj * 128 + n * 16);
#pragma unroll
            for (int m = 0; m < 4; ++m) { const size_t off = (size_t)(tok0 + r0 + wr * 64 + m * 16 + fr) * DM + col0;
#pragma unroll
                for (int bj = 0; bj < 2; ++bj)
#pragma unroll
                    for (int n = 0; n < 2; ++n) { const f32x4 o = xv[m][bj][n] + gv[bj][n] * ac[bj][m][n];
                        *(f32x4*)(xout + off + bj * 128 + n * 16) = o; ss[m] += (o[0] * o[0] + o[1] * o[1]) + (o[2] * o[2] + o[3] * o[3]); } }
        }
        TP_END(12); TP_START();
#pragma unroll
        for (int m = 0; m < 4; ++m) { float s = ss[m]; s += shx(lane, s, 16); s += shx(lane, s, 32); if (fq == 0) ssq[wc * 128 + wr * 64 + m * 16 + fr] = s; }
        wg_rewrite_fence();
        if (tid < 128) ssq[512 + tid] = 1.0f / sqrtf((ssq[tid] + ssq[128 + tid] + ssq[256 + tid] + ssq[384 + tid]) * (1.0f / DM) + EPS);
        LDS_WAIT(); __syncthreads();
        {   f32x4 wv[4], shv[4], scv[4];
#pragma unroll
            for (int j = 0; j < 4; ++j) { const int c = 4 * lane + 256 * j; wv[j] = *(const f32x4*)(nwn + c);
                if (!last) { shv[j] = *(const f32x4*)(MODn + (size_t)b * 3072 + c); scv[j] = *(const f32x4*)(MODn + (size_t)b * 3072 + 1024 + c) + 1.0f; wv[j] = wv[j] * scv[j]; } }
            for (int rr = 4 * wid; rr < 128; rr += 4 * NWAVES) {
                f32x4 xr[4][4];
#pragma unroll
                for (int i = 0; i < 4; ++i)
#pragma unroll
                    for (int j = 0; j < 4; ++j) xr[i][j] = ((const GAS f32x4*)(xout + (size_t)(tok0 + r0 + rr + i) * DM) + lane)[64 * j];
#pragma unroll
                for (int i = 0; i < 4; ++i) { const float rstd = ssq[512 + rr + i];
                    if (last) { GAS f32x4* xo = (GAS f32x4*)(xout + (size_t)(tok0 + r0 + rr + i) * DM) + lane;
#pragma unroll
                        for (int j = 0; j < 4; ++j) xo[64 * j] = xr[i][j] * rstd * wv[j]; }
                    else { GAS unsigned long long* o8 = (GAS unsigned long long*)(H + (size_t)(r0 + rr + i) * DM) + lane;
#pragma unroll
                        for (int j = 0; j < 4; ++j) { const f32x4 y = xr[i][j] * rstd * wv[j] + shv[j];
                            o8[64 * j] = (unsigned long long)pk2(y.x, y.y) | ((unsigned long long)pk2(y.z, y.w) << 32); } } }
            }
        }
        LDS_WAIT(); __syncthreads();
        TP_END(13);
    }
}

__global__ void __launch_bounds__(NWAVES * 64, 2) fwd_kernel(Args a_unused) {
    extern __shared__ __attribute__((aligned(16))) unsigned char lds[];
    volatile LAS unsigned* MISC = (volatile LAS unsigned*)((LAS unsigned char*)lds + MISC_OFF);
    for (int u = threadIdx.x; u < (LDS_BYTES - LDSCTL_OFF) / 4; u += NWAVES * 64) ((LAS unsigned*)((LAS unsigned char*)lds + LDSCTL_OFF))[u] = 0u;
    __syncthreads();
    const int wave_id = __builtin_amdgcn_readfirstlane((int)threadIdx.x >> 6);
    KArgs a0 = kargs();
    const int ph_lo = a0->ph_lo, ph_hi = a0->ph_hi;
    const bool fused = (ph_hi - ph_lo) > 1;
    XcdBarrier bar; bar.bar = (unsigned*)(a0->ws + WS_CTL) + CW_BAR; bar.x = 0; bar.st = nullptr;
    if (fused) bar = xcd_barrier_post((unsigned*)(a0->ws + WS_CTL) + CW_BAR, MISC + 8);
#ifndef PH_MASK
#define PH_MASK 0x1ff
#endif
#define IN(k) (((PH_MASK >> (k)) & 1) && ph_lo <= (k) && (k) < ph_hi)
#define SEAM() do { if (fused) { XcdBarrier b2_ = bar; asm volatile("" : "+s"(b2_.bar)); xcd_barrier(b2_); } } while (0)

#if PROBE_SEL >= 0
    volatile LAS unsigned long long* pbw = (volatile LAS unsigned long long*)((LAS unsigned char*)lds + MISC_OFF + 64);
#define PB_START() do { if (wave_id == 0) pbw[0] = __builtin_amdgcn_s_memrealtime(); } while (0)
#define PB_END(k) do { if ((k) == PROBE_SEL && wave_id == 0) { const unsigned long long v_ = pbw[1] + (__builtin_amdgcn_s_memrealtime() - pbw[0]); pbw[1] = v_; } } while (0)
#else
#define PB_START() do { } while (0)
#define PB_END(k) do { } while (0)
#endif
    PB_START();
    if (IN(0)) { KArgs a = kargs(); Frame F = mkframe(wave_id); p0_prologue(F, a, a->ws); SEAM(); }
    PB_END(0);

    const int l_lo = a0->l_lo, l_hi = a0->l_hi, g_lo = a0->g_lo, g_hi = a0->g_hi;
    for (int l = l_lo; l < l_hi; ++l)
        for (int g = g_lo; g < g_hi; ++g) {
            const int tok0 = g * MG;
            PB_START();
            if (IN(1) && (!TAIL_FUSED || l == 0)) { KArgs a = kargs(); unsigned char* ws = a->ws; Frame F = mkframe(wave_id);
                norm_phase(F, (l == 0) ? a->x : a->out, a->norm_w + l * DM, (const float*)(ws + WS_MOD) + (size_t)l * BATCH * 3072, (bf16*)(ws + WS_H + g * H_BYTES), tok0); SEAM(); }
            PB_END(1); PB_START();
            if (IN(2)) { KArgs a = kargs(); unsigned char* ws = a->ws; Frame F = mkframe(wave_id);
                pg8::Gemm gm{(const bf16*)(ws + WS_H + g * H_BYTES), (const bf16*)(ws + WS_WIN) + (size_t)l * INW * DM}; pg8::StaticOrder S; S.init(MG, INW, F.G, F.bx);
                pg8::EpiProj E{(bf16*)(ws + WS_P), a->pos + tok0, tok0};
                pg8::gemm_phase<pg8::EpiProj, pg8::StaticOrder, true, true, DM, DM, DM>(F.lds + RING_OFF, F.tid, gm, S, E);
#if DUP_G1
                pg8::gemm_phase<pg8::EpiProj, pg8::StaticOrder, true, true, DM, DM, DM>(F.lds + RING_OFF, F.tid, gm, S, E);
#endif
                SEAM();
            }
            PB_END(2); PB_START();
            if (IN(3)) { KArgs a = kargs(); unsigned char* ws = a->ws; Frame F = mkframe(wave_id);
#if ATT_NAIVE
                attn_naive_phase(F, (bf16*)(ws + WS_P), (float*)(ws + WS_LSE));
#else
                mix_phase(F, (bf16*)(ws + WS_P), (bf16*)(ws + WS_H + g * H_BYTES), (float*)(ws + WS_LSE));
#endif
                SEAM(); }
#if RET_NAIVE
            if (IN(4)) { KArgs a = kargs(); unsigned char* ws = a->ws; Frame F = mkframe(wave_id); ret_naive_phase(F, (const bf16*)(ws + WS_P), (bf16*)(ws + WS_H + g * H_BYTES)); SEAM(); }
#endif
            PB_END(3); PB_START();
#if TAIL_FUSED
            if (IN(5)) { KArgs a = kargs(); unsigned char* ws = a->ws; Frame F = mkframe(wave_id);
                const bool lastl = (l == DEPTH - 1);
                tail_phase(F, (bf16*)(ws + WS_P), (bf16*)(ws + WS_H + g * H_BYTES), (const float*)(ws + WS_LSE), a->gn_w + l * DM,
                           (const bf16*)(ws + WS_WPA) + (size_t)l * DM * 512, (const bf16*)(ws + WS_WPR) + (size_t)l * DM * DM, (const bf16*)(ws + WS_WOUT) + (size_t)l * DM * DM,
                           (l == 0) ? a->x : a->out, a->out, (const float*)(ws + WS_MOD) + (size_t)l * BATCH * 3072, (const float*)(ws + WS_MOD) + (size_t)(lastl ? l : l + 1) * BATCH * 3072,
                           lastl ? a->fnw : a->norm_w + (l + 1) * DM, tok0, lastl);
                SEAM(); }
            PB_END(5);
#else
            if (IN(5)) { KArgs a = kargs(); unsigned char* ws = a->ws; Frame F = mkframe(wave_id); combine_phase(F, (bf16*)(ws + WS_P), (const bf16*)(ws + WS_H + g * H_BYTES), (const float*)(ws + WS_LSE), a->gn_w + l * DM); SEAM(); }
            if (IN(6)) {
                { KArgs a = kargs(); unsigned char* ws = a->ws; Frame F = mkframe(wave_id);
                  pg8::Gemm gm{(const bf16*)(ws + WS_P) + pg8::C_ZA, (const bf16*)(ws + WS_WPA) + (size_t)l * DM * 512}; pg8::StaticOrder S; S.init(MG, DM, F.G, F.bx);
                  pg8::EpiGate<0> E{(bf16*)(ws + WS_P)};
                  pg8::gemm_phase<pg8::EpiGate<0>, pg8::StaticOrder, true, true, 512, pg8::LDP, 512>(F.lds + RING_OFF, F.tid, gm, S, E); }
                { KArgs a = kargs(); unsigned char* ws = a->ws; Frame F = mkframe(wave_id);
                  pg8::Gemm gm{(const bf16*)(ws + WS_P) + pg8::C_ZR, (const bf16*)(ws + WS_WPR) + (size_t)l * DM * DM}; pg8::StaticOrder S; S.init(MG, DM, F.G, F.bx);
                  pg8::EpiGate<1> E{(bf16*)(ws + WS_P)};
                  pg8::gemm_phase<pg8::EpiGate<1>, pg8::StaticOrder, true, true, DM, pg8::LDP, DM>(F.lds + RING_OFF, F.tid, gm, S, E); }
                SEAM();
            }
            if (IN(7)) { KArgs a = kargs(); unsigned char* ws = a->ws; Frame F = mkframe(wave_id);
                pg8::Gemm gm{(const bf16*)(ws + WS_P) + pg8::C_GA, (const bf16*)(ws + WS_WOUT) + (size_t)l * DM * DM}; pg8::StaticOrder S; S.init(MG, DM, F.G, F.bx);
                pg8::EpiOut E{(l == 0) ? a->x : a->out, a->out, (const float*)(ws + WS_MOD) + (size_t)l * BATCH * 3072 + 2048, tok0};
                pg8::gemm_phase<pg8::EpiOut, pg8::StaticOrder, true, true, DM, pg8::LDP, DM>(F.lds + RING_OFF, F.tid, gm, S, E);
                SEAM();
            }
#endif
        }
#if PROBE_SEL >= 0
    if (blockIdx.x == 0 && wave_id == 0) { KArgs a = kargs(); asm volatile("s_waitcnt vmcnt(0)" ::: "memory"); const float v_ = a->out[0] + (float)pbw[1] * 1e-5f; a->out[0] = v_; }
#endif
    if (IN(8) && !TAIL_FUSED) { KArgs a = kargs(); Frame F = mkframe(wave_id); final_norm_phase(F, a->out, a->fnw); }
#undef IN
#undef SEAM
}

extern "C" void kernel_launch(void* const* d_in, const int* in_sizes, int n_in, void* d_out, int out_size, void* d_ws, size_t ws_size, hipStream_t stream) {
    static int grid = 0;
    if (grid == 0) {
        if (n_in != 12 || in_sizes[0] != MTOK * DM || out_size != MTOK * DM || ws_size < WS_END) { fprintf(stderr, "kernel_launch: unexpected shapes / workspace (n_in %d, ws %zu, need %zu)\n", n_in, ws_size, (size_t)WS_END); grid = -1; return; }
        int dev = 0, cus = 0, per_cu = 0;
        if (hipGetDevice(&dev) != hipSuccess || hipDeviceGetAttribute(&cus, hipDeviceAttributeMultiprocessorCount, dev) != hipSuccess) { grid = -1; return; }
        if (hipFuncSetAttribute((const void*)fwd_kernel, hipFuncAttributeMaxDynamicSharedMemorySize, LDS_BYTES) != hipSuccess) { fprintf(stderr, "kernel_launch: hipFuncSetAttribute failed\n"); grid = -1; return; }
        if (hipOccupancyMaxActiveBlocksPerMultiprocessor(&per_cu, (const void*)fwd_kernel, NWAVES * 64, LDS_BYTES) != hipSuccess || per_cu < 1) { fprintf(stderr, "kernel_launch: occupancy query says %d\n", per_cu); }
        (void)hipGetLastError();
        grid = cus;
    }
    if (grid < 0) return;
    (void)hipMemsetAsync((char*)d_ws + WS_CTL, 0, CTL_ZERO_BYTES, stream);
    Args a{};
    a.x = (const float*)d_in[0]; a.c = (const float*)d_in[1]; a.pos = (const int*)d_in[2]; a.norm_w = (const float*)d_in[3]; a.w_ada = (const float*)d_in[4]; a.b_ada = (const float*)d_in[5];
    a.w_in = (const float*)d_in[6]; a.gn_w = (const float*)d_in[7]; a.w_pa = (const float*)d_in[8]; a.w_pr = (const float*)d_in[9]; a.w_out = (const float*)d_in[10]; a.fnw = (const float*)d_in[11];
    a.out = (float*)d_out; a.ws = (unsigned char*)d_ws;
#if MK_FUSED
    a.ph_lo = 0; a.ph_hi = 9; a.l_lo = 0; a.l_hi = DEPTH; a.g_lo = 0; a.g_hi = NGRP;
    hipLaunchKernelGGL(fwd_kernel, dim3(grid), dim3(NWAVES * 64), LDS_BYTES, stream, a);
#else
    auto launch = [&](int ph, int l, int g) { a.ph_lo = ph; a.ph_hi = ph + 1; a.l_lo = l; a.l_hi = l + 1; a.g_lo = g; a.g_hi = g + 1;
        hipLaunchKernelGGL(fwd_kernel, dim3(grid), dim3(NWAVES * 64), LDS_BYTES, stream, a); };
    a.ph_lo = 0; a.ph_hi = 1; a.l_lo = 0; a.l_hi = 0; a.g_lo = 0; a.g_hi = 0;
    hipLaunchKernelGGL(fwd_kernel, dim3(grid), dim3(NWAVES * 64), LDS_BYTES, stream, a);
    for (int l = 0; l < DEPTH; ++l) for (int g = 0; g < NGRP; ++g) for (int ph = 1; ph <= 7; ++ph) launch(ph, l, g);
    a.ph_lo = 8; a.ph_hi = 9; a.l_lo = 0; a.l_hi = 0; a.g_lo = 0; a.g_hi = 0;
    hipLaunchKernelGGL(fwd_kernel, dim3(grid), dim3(NWAVES * 64), LDS_BYTES, stream, a);
#endif
    const hipError_t le = hipPeekAtLastError();
    if (le != hipSuccess) fprintf(stderr, "kernel_launch: launch failed: %s\n", hipGetErrorName(le));
}
```

```cpp
#include <hip/hip_runtime.h>
#include <cstdio>
#include <cstdint>

#ifndef ATT_NAIVE
#define ATT_NAIVE 0
#endif
#ifndef RET_NAIVE
#define RET_NAIVE 0
#endif
#ifndef DUP_RET
#define DUP_RET 0
#endif
#ifndef DUP_ATT
#define DUP_ATT 0
#endif
#ifndef DUP_G1
#define DUP_G1 0
#endif
#ifndef DUP_TG
#define DUP_TG 0
#endif
#ifndef PROBE_SEL
#define PROBE_SEL -1
#endif
#ifndef TAIL_FUSED
#define TAIL_FUSED 1
#endif
#ifndef MK_FUSED
#define MK_FUSED 1
#endif

namespace pg8 {
#define PG8_LAS __attribute__((address_space(3)))
typedef unsigned short bf16_t;
typedef short bf16x8 __attribute__((ext_vector_type(8)));
typedef float f32x4 __attribute__((ext_vector_type(4)));
typedef unsigned u32x4 __attribute__((ext_vector_type(4)));
constexpr int BM = 256, BK = 64, HALF = 128, HTB = HALF * BK * 2  , STAGE_BYTES = 8 * HTB, NXCD = 8, WGM = 8;

__host__ __device__ __forceinline__ int lds_byte(int r, int c) { const int st = (r >> 4) * 2 + (c >> 5), rr = r & 15, cc = c & 31, ob = rr * 64 + cc * 2; return st * 1024 + (ob ^ (((ob >> 9) & 1) << 5)); }
__host__ __device__ __forceinline__ void stage_rc(int b, int& R, int& C) { const int st = b / 1024, sb = b % 1024, swz = sb ^ (((sb >> 9) & 1) << 5); R = (st >> 1) * 16 + swz / 64; C = (st & 1) * 32 + (swz % 64) / 2; }
__host__ __device__ __forceinline__ int perm32(int rho) { const int n = rho >> 4, i = rho & 15; return 8 * (i >> 2) + 4 * n + (i & 3); }

struct Unit { int pm, pn; };
struct Gemm { const bf16_t* A; const bf16_t* Bt; };

struct StaticOrder {
    int nM, nN, nwg, G, c;
    __host__ __device__ void init(int M, int N, int G_, int c_) { nM = M / BM; nN = N / BM; nwg = nM * nN; G = G_; c = c_; }
    __host__ __device__ bool next(int i, Unit& u) const {
        const long L = (long)i * G + c; if (L >= nwg) return false;
        int wgid = (int)L; { const int q = nwg / NXCD, r = nwg % NXCD, xcd = wgid % NXCD, off = wgid / NXCD; wgid = (xcd < r ? xcd * (q + 1) : r * (q + 1) + (xcd - r) * q) + off; }
        const int nig = WGM * nN, gid = wgid / nig, fm = gid * WGM, gsz = (nM - fm) < WGM ? (nM - fm) : WGM;
        u.pm = fm + ((wgid % nig) % gsz); u.pn = (wgid % nig) / gsz; return true;
    }
    __device__ __forceinline__ void a_ready(const Unit&) const {}
    __device__ __forceinline__ void done(const Unit&) const {}
};

typedef float cv_f32x2 __attribute__((ext_vector_type(2)));
typedef __bf16 cv_bf16x2 __attribute__((ext_vector_type(2)));
__device__ __forceinline__ unsigned cvt_pk_bf16(float lo, float hi) { const cv_f32x2 v = {lo, hi}; return __builtin_bit_cast(unsigned, __builtin_convertvector(v, cv_bf16x2)); }
__device__ __forceinline__ float bf_lo(unsigned w) { return __uint_as_float(w << 16); }
__device__ __forceinline__ float bf_hi(unsigned w) { return __uint_as_float(w & 0xffff0000u); }
__device__ __forceinline__ float sigmoidf_(float x) { return __builtin_amdgcn_rcpf(1.0f + __builtin_amdgcn_exp2f(-1.4426950408889634f * x)); }

constexpr int LDP = 11264;
constexpr int C_QA = 0, C_KA = 1536, C_VA = 3072, C_ZA = 4608, C_QR = 5120, C_KR = 6144, C_VR = 7168, C_ZR = 8192, C_GA = 9216, C_GR = 10240;

struct EpiProj {
    static constexpr bool PERM = true, AFTER_DRAIN = false;
    bf16_t* P; const int* pos; int tok0;
    __device__ __forceinline__ void operator()(const f32x4 (&acc)[2][2][4][2], const Unit& u, int wr, int wc, int fr, int fq) const {
        const int pn = u.pn;
        const int row0 = u.pm * BM + wr * 64 + fr, col0 = pn * BM + wc * 32 + 8 * fq;
        const int mode = (pn >= 20 && pn < 24) ? 3 : (pn >= 24 && pn < 28) ? 4 : ((pn == 18) || (pn == 19) || (pn >= 32 && pn < 36)) ? 1 : (pn >= 36) ? 2 : 0;
        if (mode < 3) {
#pragma unroll
            for (int ai = 0; ai < 2; ++ai)
#pragma unroll
                for (int m = 0; m < 4; ++m) { bf16_t* rowp = P + (size_t)(row0 + ai * HALF + m * 16) * LDP + col0;
#pragma unroll
                    for (int bj = 0; bj < 2; ++bj) { f32x4 v0 = acc[ai][bj][m][0], v1 = acc[ai][bj][m][1];
                        if (mode == 1) {
#pragma unroll
                            for (int j = 0; j < 4; ++j) { v0[j] = v0[j] * sigmoidf_(v0[j]); v1[j] = v1[j] * sigmoidf_(v1[j]); } }
                        if (mode == 2) {
#pragma unroll
                            for (int j = 0; j < 4; ++j) { v0[j] = sigmoidf_(v0[j]); v1[j] = sigmoidf_(v1[j]); } }
                        u32x4 w; w.x = cvt_pk_bf16(v0[0], v0[1]); w.y = cvt_pk_bf16(v0[2], v0[3]); w.z = cvt_pk_bf16(v1[0], v1[1]); w.w = cvt_pk_bf16(v1[2], v1[3]);
                        *(u32x4*)(rowp + bj * HALF) = w; } }
        } else {
            const int h = pn & 3;
            const float lg = __builtin_log2f(1.0f - __builtin_amdgcn_exp2f(-5.0f - (float)h));
            float irev[2][4];
#pragma unroll
            for (int n = 0; n < 2; ++n)
#pragma unroll
                for (int j = 0; j < 4; ++j) { const int i = wc * 32 + 8 * fq + 4 * n + j;
                    irev[n][j] = __builtin_amdgcn_exp2f(-(float)i * (13.287712379549449f / 128.0f)) * 0.15915494309189535f; }
            int pv[2][4];
#pragma unroll
            for (int ai = 0; ai < 2; ++ai)
#pragma unroll
                for (int m = 0; m < 4; ++m) pv[ai][m] = pos[row0 + ai * HALF + m * 16];
#pragma unroll
            for (int ai = 0; ai < 2; ++ai)
#pragma unroll
                for (int m = 0; m < 4; ++m) { const int row = row0 + ai * HALF + m * 16; bf16_t* rowp = P + (size_t)row * LDP + col0;
                    const float p = (float)pv[ai][m]; const int ic = (tok0 + row) & 127;
                    const float dec = (mode == 3) ? __builtin_amdgcn_exp2f((float)(ic - 127) * lg) : __builtin_amdgcn_exp2f((float)(127 - ic) * lg) * 0.0625f;
                    f32x4 o1[2], o2[2];
#pragma unroll
                    for (int n = 0; n < 2; ++n)
#pragma unroll
                        for (int j = 0; j < 4; ++j) { const float rv = __builtin_amdgcn_fractf(p * irev[n][j]);
                            const float sn = __builtin_amdgcn_sinf(rv), cs = __builtin_amdgcn_cosf(rv);
                            const float t1 = acc[ai][0][m][n][j], t2 = acc[ai][1][m][n][j];
                            o1[n][j] = (t1 * cs - t2 * sn) * dec; o2[n][j] = (t2 * cs + t1 * sn) * dec; }
                    u32x4 w; w.x = cvt_pk_bf16(o1[0][0], o1[0][1]); w.y = cvt_pk_bf16(o1[0][2], o1[0][3]); w.z = cvt_pk_bf16(o1[1][0], o1[1][1]); w.w = cvt_pk_bf16(o1[1][2], o1[1][3]);
                    *(u32x4*)(rowp) = w;
                    w.x = cvt_pk_bf16(o2[0][0], o2[0][1]); w.y = cvt_pk_bf16(o2[0][2], o2[0][3]); w.z = cvt_pk_bf16(o2[1][0], o2[1][1]); w.w = cvt_pk_bf16(o2[1][2], o2[1][3]);
                    *(u32x4*)(rowp + HALF) = w;
                    asm volatile("" ::: "memory"); __builtin_amdgcn_sched_barrier(0); }
        }
    }
};
template <int STEP> struct EpiGate {
    static constexpr bool PERM = true, AFTER_DRAIN = false;
    bf16_t* P;
    __device__ __forceinline__ void operator()(const f32x4 (&acc)[2][2][4][2], const Unit& u, int wr, int wc, int fr, int fq) const {
        const int row0 = u.pm * BM + wr * 64 + fr, col0 = u.pn * BM + wc * 32 + 8 * fq;
#pragma unroll
        for (int ai = 0; ai < 2; ++ai)
#pragma unroll
            for (int m = 0; m < 4; ++m) { bf16_t* rowp = P + (size_t)(row0 + ai * HALF + m * 16) * LDP + col0;
#pragma unroll
                for (int bj = 0; bj < 2; ++bj) { const f32x4 a0 = acc[ai][bj][m][0], a1 = acc[ai][bj][m][1];
                    const u32x4 g = *(const u32x4*)(rowp + C_GA + bj * HALF);
                    f32x4 v0, v1;
                    if (STEP == 0) { v0 = (f32x4){bf_lo(g.x) * a0[0], bf_hi(g.x) * a0[1], bf_lo(g.y) * a0[2], bf_hi(g.y) * a0[3]};
                                     v1 = (f32x4){bf_lo(g.z) * a1[0], bf_hi(g.z) * a1[1], bf_lo(g.w) * a1[2], bf_hi(g.w) * a1[3]}; }
                    else { const u32x4 r = *(const u32x4*)(rowp + C_GR + bj * HALF);
                        v0 = (f32x4){bf_lo(g.x) + bf_lo(r.x) * a0[0], bf_hi(g.x) + bf_hi(r.x) * a0[1], bf_lo(g.y) + bf_lo(r.y) * a0[2], bf_hi(g.y) + bf_hi(r.y) * a0[3]};
                        v1 = (f32x4){bf_lo(g.z) + bf_lo(r.z) * a1[0], bf_hi(g.z) + bf_hi(r.z) * a1[1], bf_lo(g.w) + bf_lo(r.w) * a1[2], bf_hi(g.w) + bf_hi(r.w) * a1[3]}; }
                    u32x4 w; w.x = cvt_pk_bf16(v0[0], v0[1]); w.y = cvt_pk_bf16(v0[2], v0[3]); w.z = cvt_pk_bf16(v1[0], v1[1]); w.w = cvt_pk_bf16(v1[2], v1[3]);
                    *(u32x4*)(rowp + C_GA + bj * HALF) = w; }
                asm volatile("" ::: "memory"); }
    }
};
struct EpiOut {
    static constexpr bool PERM = false, AFTER_DRAIN = false;
    const float* xin; float* xout; const float* gate; int tok0;
    __device__ __forceinline__ void operator()(const f32x4 (&acc)[2][2][4][2], const Unit& u, int wr, int wc, int fr, int fq) const {
        const int row0 = u.pm * BM + wr * 64 + fr, col0 = u.pn * BM + wc * 32 + 4 * fq;
        const int b = (tok0 + u.pm * BM) >> 11;
        f32x4 gv[2][2];
#pragma unroll
        for (int bj = 0; bj < 2; ++bj)
#pragma unroll
            for (int n = 0; n < 2; ++n) gv[bj][n] = *(const f32x4*)(gate + (size_t)b * 3072 + col0 + bj * HALF + n * 16);
#pragma unroll
        for (int ai = 0; ai < 2; ++ai)
#pragma unroll
            for (int m = 0; m < 4; ++m) { const size_t off = (size_t)(tok0 + row0 + ai * HALF + m * 16) * 1024 + col0;
#pragma unroll
                for (int bj = 0; bj < 2; ++bj)
#pragma unroll
                    for (int n = 0; n < 2; ++n) { const f32x4 xv = *(const f32x4*)(xin + off + bj * HALF + n * 16);
                        *(f32x4*)(xout + off + bj * HALF + n * 16) = xv + gv[bj][n] * acc[ai][bj][m][n]; }
                asm volatile("" ::: "memory"); }
    }
};

template <class Epi, class Sched, bool ALIGN_EPI, bool SP2, int KC, int LDA, int LDB>
__device__ __forceinline__ void gemm_phase(PG8_LAS unsigned char* lds, int tid_in, const Gemm g, const Sched& S, const Epi& E) {
    int tid_ = tid_in; asm volatile("" : "+v"(tid_));
    const int tid = tid_, wid = __builtin_amdgcn_readfirstlane(tid >> 6), lane = tid & 63, wr = wid >> 2, wc = wid & 3, fr = lane & 15, fq = lane >> 4;
    constexpr int K = KC, nt = K / BK;
    unsigned voffA[2], voffB[2];
#pragma unroll
    for (int i = 0; i < 2; ++i) { int R, C; stage_rc(tid * 16 + i * 8192, R, C); const int Rb = Epi::PERM ? ((R & ~31) + perm32(R & 31)) : R;
        voffA[i] = (unsigned)(R * LDA + C) * 2u; voffB[i] = (unsigned)(Rb * LDB + C) * 2u; }
    constexpr size_t kstep = (size_t)(BK * 2);
    constexpr size_t hstepA = (size_t)HALF * LDA * 2, hstepB = (size_t)HALF * LDB * 2;
    constexpr size_t tstepA = 2 * hstepA, tstepB = 2 * hstepB;
    const unsigned ldsw = (unsigned)wid * 1024u;
    const int aoff = lds_byte(wr * 64 + fr, fq * 8), boff = lds_byte(wc * 32 + fr, fq * 8);
#define PG8_SA(b, h) (((b) * 2 + (h)) * HTB)
#define PG8_SB(b, h) ((4 + (b) * 2 + (h)) * HTB)
#define PG8_STAGE(bufoff, gbase, voff) do { _Pragma("unroll") for (int _i = 0; _i < 2; ++_i) \
        __builtin_amdgcn_global_load_lds((const unsigned*)((const char*)(gbase) + (voff)[_i]), (PG8_LAS unsigned*)(lds + (bufoff) + ldsw + _i * 8192), 16, 0, 0); } while (0)
#define PG8_LDA(dst, b, h) do { _Pragma("unroll") for (int m = 0; m < 4; ++m) _Pragma("unroll") for (int k = 0; k < 2; ++k) dst[m][k] = *(const PG8_LAS bf16x8*)(lds + PG8_SA(b, h) + aoff + m * 2048 + k * 1024); } while (0)
#define PG8_LDB(dst, b, h) do { _Pragma("unroll") for (int n = 0; n < 2; ++n) _Pragma("unroll") for (int k = 0; k < 2; ++k) dst[n][k] = *(const PG8_LAS bf16x8*)(lds + PG8_SB(b, h) + boff + n * 2048 + k * 1024); } while (0)
#define PG8_MMA(ai, bj, At, Bt) do { __builtin_amdgcn_s_setprio(1); _Pragma("unroll") for (int m = 0; m < 4; ++m) _Pragma("unroll") for (int n = 0; n < 2; ++n) _Pragma("unroll") for (int k = 0; k < 2; ++k) \
        acc[ai][bj][m][n] = __builtin_amdgcn_mfma_f32_16x16x32_bf16(Bt[n][k], At[m][k], acc[ai][bj][m][n], 0, 0, 0); __builtin_amdgcn_s_setprio(0); } while (0)
#define PG8_WAIT_V(n) asm volatile("s_waitcnt vmcnt(" #n ")" ::: "memory")
#define PG8_WAIT_L(n) asm volatile("s_waitcnt lgkmcnt(" #n ")" ::: "memory")
#define PG8_BAR __builtin_amdgcn_s_barrier()
#define PG8_SCHED __builtin_amdgcn_sched_barrier(0)
    Unit cur, nxt; int ui = 0;
    if (!S.next(0, cur)) return;
    f32x4 acc[2][2][4][2];
#pragma unroll
    for (int a = 0; a < 2; ++a)
#pragma unroll
        for (int b = 0; b < 2; ++b)
#pragma unroll
            for (int m = 0; m < 4; ++m)
#pragma unroll
                for (int n = 0; n < 2; ++n) acc[a][b][m][n] = (f32x4){0.f, 0.f, 0.f, 0.f};
    bf16x8 At[4][2], B0[2][2], B1[2][2];
    const char* cA = (const char*)g.A + (size_t)cur.pm * tstepA; const char* cB = (const char*)g.Bt + (size_t)cur.pn * tstepB;
    S.a_ready(cur);
    if constexpr (SP2) {
        PG8_STAGE(PG8_SB(0, 0), cB, voffB); PG8_STAGE(PG8_SB(0, 1), cB + hstepB, voffB); PG8_STAGE(PG8_SA(0, 0), cA, voffA); PG8_STAGE(PG8_SA(0, 1), cA + hstepA, voffA);
        if (wr == 1) PG8_BAR;
        PG8_WAIT_V(2); PG8_BAR;
        PG8_STAGE(PG8_SB(1, 0), cB + kstep, voffB); PG8_STAGE(PG8_SA(1, 0), cA + kstep, voffA); PG8_STAGE(PG8_SB(1, 1), cB + hstepB + kstep, voffB);
        PG8_WAIT_V(6); PG8_BAR;
    } else {
        PG8_STAGE(PG8_SB(0, 0), cB, voffB); PG8_STAGE(PG8_SA(0, 0), cA, voffA); PG8_STAGE(PG8_SB(0, 1), cB + hstepB, voffB); PG8_STAGE(PG8_SA(0, 1), cA + hstepA, voffA);
        if (wr == 1) PG8_BAR;
        PG8_WAIT_V(4); PG8_BAR;
        PG8_STAGE(PG8_SB(1, 0), cB + kstep, voffB); PG8_STAGE(PG8_SA(1, 0), cA + kstep, voffA); PG8_STAGE(PG8_SB(1, 1), cB + hstepB + kstep, voffB);
        PG8_WAIT_V(6); PG8_BAR;
    }
    for (;;) {
        const bool has_next = S.next(ui + 1, nxt);
        const char* nA = has_next ? (const char*)g.A + (size_t)nxt.pm * tstepA : cA; const char* nB = has_next ? (const char*)g.Bt + (size_t)nxt.pn * tstepB : cB;
        for (int t = 0; t < nt; t += 2) {
            const bool last = (t == nt - 2);
            const char* a1 = cA + (size_t)(t + 1) * kstep;
            const char* a2 = last ? nA : cA + (size_t)(t + 2) * kstep; const char* b2 = last ? nB : cB + (size_t)(t + 2) * kstep;
            const char* a3 = a2 + kstep; const char* b3 = b2 + kstep;
            if (last && has_next) S.a_ready(nxt);
            if constexpr (SP2) {
            PG8_LDB(B0, 0, 0); PG8_LDB(B1, 0, 1); PG8_SCHED; PG8_LDA(At, 0, 0); PG8_STAGE(PG8_SA(1, 1), a1 + hstepA, voffA);
            PG8_WAIT_V(8); PG8_WAIT_L(0); PG8_BAR; PG8_MMA(0, 0, At, B0); PG8_MMA(0, 1, At, B1); PG8_BAR; PG8_SCHED;
            PG8_LDA(At, 0, 1); PG8_STAGE(PG8_SB(0, 0), b2, voffB); PG8_STAGE(PG8_SB(0, 1), b2 + hstepB, voffB); PG8_STAGE(PG8_SA(0, 0), a2, voffA);
            PG8_WAIT_V(8); PG8_WAIT_L(0); PG8_BAR; PG8_MMA(1, 0, At, B0); PG8_MMA(1, 1, At, B1); PG8_BAR; PG8_SCHED;
            PG8_LDB(B0, 1, 0); PG8_LDB(B1, 1, 1); PG8_SCHED; PG8_LDA(At, 1, 0); PG8_STAGE(PG8_SA(0, 1), a2 + hstepA, voffA);
            PG8_WAIT_V(8); PG8_WAIT_L(0); PG8_BAR; PG8_MMA(0, 0, At, B0); PG8_MMA(0, 1, At, B1); PG8_BAR; PG8_SCHED;
            PG8_LDA(At, 1, 1); PG8_STAGE(PG8_SB(1, 0), b3, voffB); PG8_STAGE(PG8_SB(1, 1), b3 + hstepB, voffB); PG8_STAGE(PG8_SA(1, 0), a3, voffA);
            PG8_WAIT_V(8); PG8_WAIT_L(0); PG8_BAR; PG8_MMA(1, 0, At, B0); PG8_MMA(1, 1, At, B1); PG8_BAR; PG8_SCHED;
            } else {
            PG8_LDB(B0, 0, 0); PG8_SCHED; PG8_LDA(At, 0, 0); PG8_STAGE(PG8_SA(1, 1), a1 + hstepA, voffA);
            PG8_WAIT_L(8); PG8_BAR; PG8_WAIT_L(0); PG8_MMA(0, 0, At, B0); PG8_BAR; PG8_SCHED;
            PG8_LDB(B1, 0, 1); PG8_STAGE(PG8_SB(0, 0), b2, voffB);
            PG8_BAR; PG8_WAIT_L(0); PG8_MMA(0, 1, At, B1); PG8_BAR;
            PG8_LDA(At, 0, 1); PG8_STAGE(PG8_SA(0, 0), a2, voffA);
            PG8_BAR; PG8_WAIT_L(0); PG8_MMA(1, 0, At, B0); PG8_BAR; PG8_SCHED;
            PG8_STAGE(PG8_SB(0, 1), b2 + hstepB, voffB);
            PG8_WAIT_V(6); PG8_BAR; PG8_MMA(1, 1, At, B1); PG8_BAR;
            PG8_LDB(B0, 1, 0); PG8_SCHED; PG8_LDA(At, 1, 0); PG8_STAGE(PG8_SA(0, 1), a2 + hstepA, voffA);
            PG8_WAIT_L(8); PG8_BAR; PG8_WAIT_L(0); PG8_MMA(0, 0, At, B0); PG8_BAR; PG8_SCHED;
            PG8_LDB(B1, 1, 1); PG8_STAGE(PG8_SB(1, 0), b3, voffB);
            PG8_BAR; PG8_WAIT_L(0); PG8_MMA(0, 1, At, B1); PG8_BAR;
            PG8_LDA(At, 1, 1); PG8_STAGE(PG8_SA(1, 0), a3, voffA);
            PG8_BAR; PG8_WAIT_L(0); PG8_MMA(1, 0, At, B0); PG8_BAR; PG8_SCHED;
            PG8_STAGE(PG8_SB(1, 1), b3 + hstepB, voffB);
            PG8_WAIT_V(6); PG8_BAR; PG8_MMA(1, 1, At, B1); PG8_BAR;
            }
        }
        if constexpr (ALIGN_EPI) { if (wr == 0) PG8_BAR; }
        if constexpr (!Epi::AFTER_DRAIN) { E(acc, cur, wr, wc, fr, fq); S.done(cur); }
        if (!has_next) break;
#pragma unroll
        for (int a = 0; a < 2; ++a)
#pragma unroll
            for (int b = 0; b < 2; ++b)
#pragma unroll
                for (int m = 0; m < 4; ++m)
#pragma unroll
                    for (int n = 0; n < 2; ++n) acc[a][b][m][n] = (f32x4){0.f, 0.f, 0.f, 0.f};
        cur = nxt; cA = nA; cB = nB; ++ui;
        if constexpr (ALIGN_EPI) { if (wr == 1) PG8_BAR; }
    }
    PG8_WAIT_V(0);
    if constexpr (!ALIGN_EPI) { if (wr == 0) PG8_BAR; }
    PG8_BAR;
    if constexpr (Epi::AFTER_DRAIN) { E.fused(acc, cur, wr, wc, fr, fq, lds, wid, lane); S.done(cur); }
#undef PG8_SA
#undef PG8_SB
#undef PG8_STAGE
#undef PG8_LDA
#undef PG8_LDB
#undef PG8_MMA
#undef PG8_WAIT_V
#undef PG8_WAIT_L
#undef PG8_BAR
#undef PG8_SCHED
}
}

#define GAS __attribute__((address_space(1)))
#define LAS __attribute__((address_space(3)))
typedef unsigned short bf16;
typedef unsigned v4u __attribute__((ext_vector_type(4)));
typedef float f32x4 __attribute__((ext_vector_type(4)));
typedef short bf16x8 __attribute__((ext_vector_type(8)));
typedef GAS unsigned gu32;
typedef GAS unsigned long long gu64;
#define RLX_AGENT __ATOMIC_RELAXED, __HIP_MEMORY_SCOPE_AGENT
#define LDS_WAIT() asm volatile("s_waitcnt lgkmcnt(0)" ::: "memory")
#define VM_WAIT() asm volatile("s_waitcnt vmcnt(0)" ::: "memory")
__device__ __forceinline__ unsigned long long rt() { return __builtin_amdgcn_s_memrealtime(); }
__device__ __forceinline__ unsigned f2bf(float f) { unsigned u = __builtin_bit_cast(unsigned, f); return (u + 0x7fffu + ((u >> 16) & 1u)) >> 16; }
__device__ __forceinline__ unsigned pk2(float lo, float hi) { return f2bf(lo) | (f2bf(hi) << 16); }

#define XB_TMO      128
#define XB_XCNT(j)  (256  + 64 * (j))
#define XB_XSUB(j)  (1280 + 64 * (j))
#define XB_XGEN(j)  (2304 + 64 * (j))
#define XB_TOP      3328
#define XB_TOPGEN   3392
#define XCD_BAR_WORDS 3456
#define XB_SPIN_CAP (1u << 18)

__device__ __forceinline__ unsigned xb_ld(unsigned* p)              { return __hip_atomic_load(p, __ATOMIC_RELAXED, __HIP_MEMORY_SCOPE_AGENT); }
__device__ __forceinline__ unsigned xb_add(unsigned* p, unsigned v) { return __hip_atomic_fetch_add(p, v, __ATOMIC_RELAXED, __HIP_MEMORY_SCOPE_AGENT); }
__device__ __forceinline__ unsigned xb_xcc_id() { return (unsigned)__builtin_amdgcn_s_getreg((3 << 11) | 20) & 0xFu; }
#define XB_SPIN(cond, bar) do { unsigned _sp = 0; while (cond) { __builtin_amdgcn_s_sleep(1); \
    if ((++_sp & 255u) == 0u) { if (xb_ld(&(bar)[XB_TMO])) break; if (_sp > XB_SPIN_CAP) { atomicAdd(&(bar)[XB_TMO], 1u); break; } } } } while (0)

struct XcdBarrier {
    unsigned* bar; unsigned x;
    volatile LAS unsigned* st;
};

__device__ __forceinline__ XcdBarrier xcd_barrier_post(unsigned* bar, volatile LAS unsigned* st) {
    XcdBarrier b; b.bar = bar; b.x = xb_xcc_id(); b.st = st;
    if (threadIdx.x == 0) (void)xb_add(&bar[XB_XCNT(b.x)], 1u);
    return b;
}
__device__ __forceinline__ void xcd_barrier_complete(unsigned* bar, unsigned x, unsigned& nloc, unsigned& nx) {
    const unsigned G = gridDim.x * gridDim.y * gridDim.z;
    unsigned sum, cnt, mine, sp = 0u;
    for (;;) {
        sum = 0u; cnt = 0u; mine = 0u;
#pragma unroll
        for (unsigned j = 0; j < 16; ++j) { const unsigned c = xb_ld(&bar[XB_XCNT(j)]); sum += c; cnt += (c > 0u) ? 1u : 0u; mine = (j == x) ? c : mine; }
        if (sum == G) break;
        __builtin_amdgcn_s_sleep(1);
        if ((++sp & 255u) == 0u) { if (xb_ld(&bar[XB_TMO])) break; if (sp > XB_SPIN_CAP) { atomicAdd(&bar[XB_TMO], 1u); break; } }
    }
    nloc = mine > 0u ? mine : 1u; nx = cnt > 0u ? cnt : 1u;
}

__device__ __forceinline__ void xcd_barrier(const XcdBarrier& b) {
    asm volatile("s_waitcnt vmcnt(0)" ::: "memory");
    __syncthreads();
    if (threadIdx.x == 0) {
        unsigned* bar = b.bar;
        __builtin_amdgcn_s_waitcnt(0);
        unsigned nloc = b.st[0], nx = b.st[1];
        if (nloc == 0u) { xcd_barrier_complete(bar, b.x, nloc, nx); b.st[0] = nloc; b.st[1] = nx; }
        const unsigned old = xb_add(&bar[XB_XSUB(b.x)], 1u);
        const unsigned gen = old / nloc;
        if (old + 1u == (gen + 1u) * nloc) {
            __builtin_amdgcn_fence(__ATOMIC_RELEASE, "agent");
            asm volatile("s_waitcnt vmcnt(0)" ::: "memory");
            const unsigned og = xb_add(&bar[XB_TOP], 1u);
            const unsigned tg = og / nx;
            if (og + 1u == (tg + 1u) * nx) xb_add(&bar[XB_TOPGEN], 1u);
            else XB_SPIN(xb_ld(&bar[XB_TOPGEN]) == tg, bar);
            __builtin_amdgcn_fence(__ATOMIC_ACQUIRE, "agent");
            xb_add(&bar[XB_XGEN(b.x)], 1u);
            asm volatile("s_waitcnt vmcnt(0)" ::: "memory");
        } else {
            XB_SPIN(xb_ld(&bar[XB_XGEN(b.x)]) == gen, bar);
            __builtin_amdgcn_fence(__ATOMIC_ACQUIRE, "agent");
            asm volatile("s_waitcnt vmcnt(0)" ::: "memory");
        }
    }
    __syncthreads();
}


namespace att {
typedef unsigned short bf16;
typedef short bf16x8 __attribute__((ext_vector_type(8)));
typedef short s16x4 __attribute__((ext_vector_type(4)));
typedef float f32x16 __attribute__((ext_vector_type(16)));
typedef float f32x4 __attribute__((ext_vector_type(4)));
typedef unsigned u32x4 __attribute__((ext_vector_type(4)));
constexpr float SCALE = 0.08838834764831845f;
constexpr int NW = 8, QBLK = 32, KVBLK = 64, QB = NW * QBLK, D = 128, LDP = 11264;
constexpr int SHM_V = KVBLK * D * 2, SHM_K = KVBLK * D * 2;
constexpr int LDS_BYTES = 2 * SHM_V + 2 * SHM_K + NW * 64 * 4;
constexpr float THR = 8.f;
constexpr bool SK = true;

#define KSWZ(row, colB) ((row) * 256 + ((colB) ^ (((row) & 7) << 4)))
#define SBAR() __builtin_amdgcn_sched_barrier(0)
__device__ __forceinline__ int v_st(int k, int c) { const int kk = (k & ~0xC) | ((k & 4) << 1) | ((k & 8) >> 1); return ((kk >> 3) * 4 + (c >> 5)) * 512 + ((kk & 7) * 32 + (c & 31)) * 2; }
__device__ __forceinline__ int v_rd_base(int lane) { return ((lane & 3) << 3) | (((lane >> 2) & 3) << 6) | (((lane >> 4) & 1) << 5) | (((lane >> 5) & 1) << 8); }
constexpr int v_rd_off(int d0, int ks, int half) { return d0 * 512 + ks * 4096 + half * 2048; }
__device__ __forceinline__ int crow(int r, int hi) { return (r & 3) + 8 * (r >> 2) + 4 * hi; }
__device__ __forceinline__ unsigned cvtpk(float lo, float hi) { return pg8::cvt_pk_bf16(lo, hi); }
__device__ __forceinline__ bf16x8 load8(const bf16* p) { return *reinterpret_cast<const bf16x8*>(p); }
__device__ __forceinline__ void mask_tile(f32x16& p0, f32x16& p1, int dq, unsigned W) {
    const float NEG = -__builtin_inff();
#pragma unroll
    for (int r = 0; r < 16; ++r) {
        const int c = (r & 3) + 8 * (r >> 2);
        if ((unsigned)(dq - c) >= W) p0[r] = NEG;
        if ((unsigned)(dq - c - 32) >= W) p1[r] = NEG;
    }
}
__device__ __forceinline__ void partialSM(f32x16& p0, f32x16& p1, float& m_reg, float& mn, float& alpha) {
    float pmax = p0[0]; for (int r = 1; r < 16; ++r) pmax = fmaxf(pmax, p0[r]); for (int r = 0; r < 16; ++r) pmax = fmaxf(pmax, p1[r]);
    { auto rr = __builtin_amdgcn_permlane32_swap(__float_as_uint(pmax), __float_as_uint(pmax), false, false);
      pmax = fmaxf(__uint_as_float(rr[0]), __uint_as_float(rr[1])); }
    constexpr float C2 = 1.4426950408889634f * SCALE;
    if (__builtin_expect(__all((pmax - m_reg) * SCALE <= THR), 1)) { mn = m_reg; alpha = 1.f; }
    else { mn = fmaxf(m_reg, pmax); alpha = __builtin_amdgcn_exp2f((m_reg - mn) * C2); m_reg = mn; }
    const float mnL = -mn * C2;
    for (int r = 0; r < 16; ++r) p0[r] = fmaf(p0[r], C2, mnL); for (int r = 0; r < 16; ++r) p1[r] = fmaf(p1[r], C2, mnL);
    for (int r = 0; r < 16; ++r) p0[r] = __builtin_amdgcn_exp2f(p0[r]);
}
__device__ __forceinline__ void finishSM(f32x16& p0, f32x16& p1, float alpha, float& l_reg, bf16x8& pa0, bf16x8& pa1, bf16x8& pa2, bf16x8& pa3) {
    for (int r = 0; r < 16; ++r) p1[r] = __builtin_amdgcn_exp2f(p1[r]);
    float ps = 0; for (int r = 0; r < 16; ++r) ps += p0[r]; for (int r = 0; r < 16; ++r) ps += p1[r];
    { auto rr = __builtin_amdgcn_permlane32_swap(__float_as_uint(ps), __float_as_uint(ps), false, false);
      ps = __uint_as_float(rr[0]) + __uint_as_float(rr[1]); }
    l_reg = l_reg * alpha + ps;
#define PK4(P, B_, OUT) do { unsigned a0 = cvtpk(P[B_+0], P[B_+1]), a1 = cvtpk(P[B_+2], P[B_+3]);                          \
        unsigned b0 = cvtpk(P[B_+4], P[B_+5]), b1 = cvtpk(P[B_+6], P[B_+7]);                                             \
        auto r0 = __builtin_amdgcn_permlane32_swap(a0, b0, false, false); auto r1 = __builtin_amdgcn_permlane32_swap(a1, b1, false, false); \
        u32x4 w = {r0[0], r1[0], r0[1], r1[1]}; OUT = *reinterpret_cast<bf16x8*>(&w); } while (0)
    PK4(p0, 0, pa0); PK4(p0, 8, pa1); PK4(p1, 0, pa2); PK4(p1, 8, pa3);
#undef PK4
}
template <int KB>
__device__ __forceinline__ void qkt(f32x16& p0, f32x16& p1, const char* K_lds, int r32, int hi, const bf16x8* qr, bool act) {
    if (SK && !act) { const float NEG = -__builtin_inff();
#pragma unroll
        for (int r = 0; r < 16; ++r) { p0[r] = NEG; p1[r] = NEG; } return; }
    p0 = f32x16{}; p1 = f32x16{};
    const char* kb[4];
#pragma unroll
    for (int dd = 0; dd < 4; ++dd) kb[dd] = K_lds + KB * SHM_K + KSWZ(r32, (dd * 16 + hi * 8) * 2);
#pragma unroll
    for (int d0 = 0; d0 < 8; ++d0) { const char* a = kb[d0 & 3] + (d0 >> 2) * 128;
        bf16x8 b0 = *reinterpret_cast<const bf16x8*>(a);
        bf16x8 b1 = *reinterpret_cast<const bf16x8*>(a + 32 * 256);
        p0 = __builtin_amdgcn_mfma_f32_32x32x16_bf16(b0, qr[d0], p0, 0, 0, 0);
        p1 = __builtin_amdgcn_mfma_f32_32x32x16_bf16(b1, qr[d0], p1, 0, 0, 0); }
}
template <int VB>
__device__ __forceinline__ void pv_tile(f32x16* o, int vb0, bf16x8 pa0, bf16x8 pa1, bf16x8 pa2, bf16x8 pa3, bool act) {
    if (SK && !act) return;
#define TRRD(dst, off) asm volatile("ds_read_b64_tr_b16 %0, %1 offset:%2" : "=&v"(dst) : "v"(vb0), "i"(off) : "memory")
#define PV_D0(d0) do { s16x4 l0, l1, l2, l3, h0, h1, h2, h3; constexpr int b_ = VB * SHM_V + v_rd_off(d0, 0, 0); \
        TRRD(l0, b_); TRRD(h0, b_ + 2048); TRRD(l1, b_ + 4096); TRRD(h1, b_ + 6144); TRRD(l2, b_ + 8192); TRRD(h2, b_ + 10240); TRRD(l3, b_ + 12288); TRRD(h3, b_ + 14336); \
        asm volatile("s_waitcnt lgkmcnt(0)" ::: "memory"); SBAR();   \
        o[d0] = __builtin_amdgcn_mfma_f32_32x32x16_bf16(pa0, (bf16x8){l0[0], l0[1], l0[2], l0[3], h0[0], h0[1], h0[2], h0[3]}, o[d0], 0, 0, 0);   \
        o[d0] = __builtin_amdgcn_mfma_f32_32x32x16_bf16(pa1, (bf16x8){l1[0], l1[1], l1[2], l1[3], h1[0], h1[1], h1[2], h1[3]}, o[d0], 0, 0, 0);   \
        o[d0] = __builtin_amdgcn_mfma_f32_32x32x16_bf16(pa2, (bf16x8){l2[0], l2[1], l2[2], l2[3], h2[0], h2[1], h2[2], h2[3]}, o[d0], 0, 0, 0);   \
        o[d0] = __builtin_amdgcn_mfma_f32_32x32x16_bf16(pa3, (bf16x8){l3[0], l3[1], l3[2], l3[3], h3[0], h3[1], h3[2], h3[3]}, o[d0], 0, 0, 0); } while (0)
    PV_D0(0); PV_D0(1); PV_D0(2); PV_D0(3);
#undef PV_D0
#undef TRRD
}
struct BlockRef { bf16* Q; float* L; int P0, dsh, lmask, lsh, g2; };
constexpr int KOFF = 1536, VOFF = 3072;
__device__ __forceinline__ int tokoff(const BlockRef& r, int v) { return ((v & r.lmask) << r.dsh) + (v >> r.lsh); }
struct Seam { bf16x8 qr[8]; bf16x8 st_v0, st_v1, st_k0, st_k1; };
__device__ __forceinline__ int blk_jlo(const BlockRef& r) { const int lowk = r.g2 ? r.P0 : r.P0 - 128; return lowk > 0 ? lowk / KVBLK : 0; }
#define ROWC(ref, p, k0, rr) ((p) + (size_t)tokoff(ref, (k0) + (rr)) * LDP + sc)
#define VMW() asm volatile("s_waitcnt vmcnt(0)" ::: "memory")
#define VMWN(n) asm volatile("s_waitcnt vmcnt(%0)" :: "i"(n) : "memory")
#define SLOAD_H(ref, k0) do { const bf16* r0_ = ROWC(ref, (ref).Q, k0, sr); const bf16* r1_ = ROWC(ref, (ref).Q, k0, 32 + sr);              \
                              S.st_v0 = load8(r0_ + VOFF); S.st_v1 = load8(r1_ + VOFF); S.st_k0 = load8(r0_ + KOFF); S.st_k1 = load8(r1_ + KOFF); } while (0)
#define SWRITE_HK(bf) do { *(bf16x8*)(K_lds + (bf) * SHM_K + kws) = S.st_k0; *(bf16x8*)(K_lds + (bf) * SHM_K + kws + 32 * 256) = S.st_k1; } while (0)
#define SWRITE_HV(bf) do { *(bf16x8*)(V_lds + (bf) * SHM_V + vst0) = S.st_v0; *(bf16x8*)(V_lds + (bf) * SHM_V + vst1) = S.st_v1; } while (0)
#define SWRITE_H(bf) do { SWRITE_HV(bf); SWRITE_HK(bf); } while (0)
__device__ __forceinline__ void swa_prime(const BlockRef& cur, char* lds, Seam& S, int tid) {
    const int wid = __builtin_amdgcn_readfirstlane(tid >> 6), lane = tid & 63, r32 = lane & 31, hi = lane >> 5;
    const int sr = tid >> 4, sc = (tid & 15) * 8, kws = KSWZ(sr, sc * 2); char* K_lds = lds + 2 * SHM_V;
    const int kb0 = blk_jlo(cur) * KVBLK;
    { const bf16* qrow = cur.Q + (size_t)tokoff(cur, cur.P0 + wid * QBLK + r32) * LDP + hi * 8;
#pragma unroll
      for (int d0 = 0; d0 < 8; ++d0) S.qr[d0] = load8(qrow + d0 * 16); }
    SLOAD_H(cur, kb0); VMW(); SWRITE_HK(0);
    __syncthreads();
}
__device__ __forceinline__ void swa_block(const BlockRef& cur, const BlockRef& nxt, char* lds, Seam& S, int tid_in, bool dry = false) {
    int tid = tid_in; asm volatile("" : "+v"(tid));
    const int wid = __builtin_amdgcn_readfirstlane(tid >> 6), lane = tid & 63, r32 = lane & 31, hi = lane >> 5;
    const int j_lo = blk_jlo(cur), j_hi = (cur.P0 + QB - 1) / KVBLK + 1;
    const int NT = j_hi - j_lo;
    const int kbn = blk_jlo(nxt) * KVBLK;
    const int qlo = cur.P0 + wid * QBLK, qm = qlo + r32 - 4 * hi;
    const unsigned Wl = cur.g2 ? (unsigned)(((qlo + r32) & 127) + 1) : 129u;
    const int wklo = cur.g2 ? (qlo & ~127) : qlo - 128;
    const int wklo_last = cur.g2 ? (qlo & ~127) : qlo - 97;
    char* V_lds = lds; char* K_lds = lds + 2 * SHM_V;
    float* wsl = (float*)(lds + 2 * SHM_V + 2 * SHM_K) + wid * 64; float* li_l = wsl, * al_l = wsl + 32;
    float m_reg = -1e30f, l_reg = 0; f32x16 o[4] = {};
    const int sr = tid >> 4, sc = (tid & 15) * 8, vst0 = v_st(sr, sc), vst1 = v_st(32 + sr, sc), kws = KSWZ(sr, sc * 2);
    const int vb0 = (int)(uintptr_t)V_lds + v_rd_base(lane);
#define RESC(a) do { if (__any((a) < 1.f)) { if (hi == 0) al_l[r32] = (a); asm volatile("s_waitcnt lgkmcnt(0)" ::: "memory");              \
                     for (int d_ = 0; d_ < 4; ++d_) for (int r = 0; r < 16; ++r) o[d_][r] *= al_l[crow(r, hi)]; } } while (0)
#define KBASE(t) ((j_lo + (t)) * KVBLK)
#define ACT(t) (KBASE(t) <= qlo + QBLK - 1 && KBASE(t) + KVBLK - 1 >= wklo)
#define MASKT(P0_, P1_, t) do { const int kb_ = KBASE(t); if ((!SK || ACT(t)) && (kb_ + KVBLK - 1 > qlo || kb_ < wklo_last)) mask_tile(P0_, P1_, qm - kb_, Wl); } while (0)
    constexpr int NQL = 8;
#define SEAM_K0() do { VMWN(NQL); SWRITE_HK(0); SBAR(); } while (0)
    f32x16 pA0, pA1, pB0, pB1; float mnA, mnB, alA, alB; bf16x8 pa0, pa1, pa2, pa3;
    SWRITE_HV(0); SBAR();
    if (NT > 1) { SLOAD_H(cur, KBASE(1)); }
    SBAR(); qkt<0>(pA0, pA1, K_lds, r32, hi, S.qr, ACT(0));
    MASKT(pA0, pA1, 0); partialSM(pA0, pA1, m_reg, mnA, alA);
    if (NT > 1) { VMW(); SWRITE_H(1); }
    __syncthreads();
#define HALF_STEP(PX0, PX1, mnX, alX, PY0, PY1, alY, t, KB, VB, SB) do {                                                      \
        SBAR(); qkt<KB>(PX0, PX1, K_lds, r32, hi, S.qr, ACT(t));                                             \
        finishSM(PY0, PY1, alY, l_reg, pa0, pa1, pa2, pa3); SBAR();                                                           \
        if ((t) + 1 < NT) { SLOAD_H(cur, KBASE((t) + 1)); SBAR(); }                                               \
        pv_tile<VB>(o, vb0, pa0, pa1, pa2, pa3, ACT((t) - 1)); MASKT(PX0, PX1, (t)); partialSM(PX0, PX1, m_reg, mnX, alX);                                        \
        __syncthreads();                                                                                                      \
        if ((t) + 1 < NT) { VMW(); SWRITE_H(SB); }                                                                          \
        RESC(alX); __syncthreads(); } while (0)
    for (int t = 1; t + 1 < NT; t += 2) {
        HALF_STEP(pB0, pB1, mnB, alB, pA0, pA1, alA, t, 1, 0, 0);
        HALF_STEP(pA0, pA1, mnA, alA, pB0, pB1, alB, t + 1, 0, 1, 1);
    }
    const bool even = (NT & 1) == 0;
    if (even) { SBAR(); qkt<1>(pB0, pB1, K_lds, r32, hi, S.qr, ACT(NT - 1)); SBAR(); }
    SLOAD_H(nxt, kbn); SBAR();
    { const bf16* qrow = nxt.Q + (size_t)tokoff(nxt, nxt.P0 + wid * QBLK + r32) * LDP + hi * 8;
#pragma unroll
      for (int d0 = 0; d0 < 8; ++d0) S.qr[d0] = load8(qrow + d0 * 16); }
    SBAR();
    finishSM(pA0, pA1, alA, l_reg, pa0, pa1, pa2, pa3); SBAR();
    pv_tile<0>(o, vb0, pa0, pa1, pa2, pa3, ACT(even ? NT - 2 : NT - 1));
    if (even) { MASKT(pB0, pB1, NT - 1); partialSM(pB0, pB1, m_reg, mnB, alB); __syncthreads(); RESC(alB);
        finishSM(pB0, pB1, alB, l_reg, pa0, pa1, pa2, pa3); SBAR(); pv_tile<1>(o, vb0, pa0, pa1, pa2, pa3, ACT(NT - 1)); }
    SBAR(); SEAM_K0();
    if (hi == 0) { li_l[r32] = l_reg; if (!dry) cur.L[(size_t)tokoff(cur, qlo + r32) * 12] = m_reg * SCALE + __logf(l_reg); }
    asm volatile("s_waitcnt lgkmcnt(0)" ::: "memory");
#pragma unroll
    for (int r = 0; r < 16; ++r) { const int orow = crow(r, hi); const float rli = __builtin_amdgcn_rcpf(li_l[orow]);
        bf16* Ow = cur.Q + (size_t)tokoff(cur, qlo + orow) * LDP;
#pragma unroll
        for (int d0 = 0; d0 < 4; ++d0) { const float v = o[d0][r] * rli; const float vn = __uint_as_float((unsigned)__builtin_amdgcn_ds_bpermute((lane ^ 1) << 2, (int)__float_as_uint(v)));
            if ((r32 & 1) == 0 && !dry) *(unsigned*)(Ow + d0 * 32 + r32) = cvtpk(v, vn); } }
    __syncthreads();
#undef RESC
#undef KBASE
#undef ACT
#undef MASKT
#undef SEAM_K0
#undef HALF_STEP
}
#undef ROWC
#undef VMW
#undef VMWN
#undef SLOAD_H
#undef SWRITE_HK
#undef SWRITE_HV
#undef SWRITE_H
#undef KSWZ
#undef SBAR
}


namespace ret {
typedef unsigned short bf16;
typedef short bf16x8 __attribute__((ext_vector_type(8)));
typedef short s16x4 __attribute__((ext_vector_type(4)));
typedef float f32x4 __attribute__((ext_vector_type(4)));
typedef unsigned u32x4 __attribute__((ext_vector_type(4)));
typedef unsigned u32x2 __attribute__((ext_vector_type(2)));
#define RLAS __attribute__((address_space(3)))
constexpr int LDP = 11264, QBO = 0, KBO = 32768, VBO = 65536, PBO = 98304;
__device__ __forceinline__ unsigned cvtpk(float lo, float hi) { return pg8::cvt_pk_bf16(lo, hi); }
__device__ __forceinline__ bf16x8 mk8(unsigned a, unsigned b, unsigned c, unsigned d) { u32x4 w = {a, b, c, d}; return *reinterpret_cast<bf16x8*>(&w); }
#define RET_TR(dst, addr, off) asm volatile("ds_read_b64_tr_b16 %0, %1 offset:%2" : "=&v"(dst) : "v"(addr), "i"(off) : "memory")
#define RET_LW() do { asm volatile("s_waitcnt lgkmcnt(0)" ::: "memory"); __builtin_amdgcn_sched_barrier(0); } while (0)
#define RET_MFMA(a, b, c) __builtin_amdgcn_mfma_f32_16x16x32_bf16(a, b, c, 0, 0, 0)

__device__ __forceinline__ void ret_unit(RLAS unsigned char* lds, int tid_in, const bf16* Pq, bf16* Ho, int eh, int h) {
    int tid = tid_in; asm volatile("" : "+v"(tid));
    const int w = __builtin_amdgcn_readfirstlane(tid >> 6), lane = tid & 63, l15 = lane & 15, q = lane >> 4;
    const float lg = __builtin_log2f(1.0f - __builtin_amdgcn_exp2f(-5.0f - (float)h)), cd = __builtin_amdgcn_exp2f(128.0f * lg);
    const unsigned lb = (unsigned)(size_t)lds;
    const int xr = ((l15 & 3) << 2) | ((l15 >> 2) & 3);
    const unsigned rowA = 256u * l15 + 16u * (unsigned)(q ^ xr);
    const unsigned rowB = 256u * l15 + 16u * (unsigned)((q >> 1) ^ xr) + 8u * (q & 1);
    const unsigned pwr = PBO + 256u * l15 + 16u * (unsigned)((2 * w + (q >> 1)) ^ xr) + 8u * (q & 1);
    const int qq = l15 >> 2, p = lane & 3;
    unsigned trb[2];
#pragma unroll
    for (int t = 0; t < 2; ++t) trb[t] = 256u * (8 * q + 4 * t + qq) + 16u * (unsigned)((p >> 1) ^ ((qq << 2) | ((2 * q + t) & 3))) + 8u * (p & 1);
    const int srow = tid >> 4, sch = tid & 15;
    const unsigned stw = 256u * srow + 16u * (unsigned)(sch ^ ((((srow) & 3) << 2) | ((srow >> 2) & 3)));
    const bf16* gq = Pq + (size_t)srow * LDP + sch * 8;

    f32x4 S[16];
#pragma unroll
    for (int i = 0; i < 16; ++i) S[i] = (f32x4){0.f, 0.f, 0.f, 0.f};

    for (int n = 0; n < 16; ++n) {
        const bf16* gc = gq + (size_t)(128 * n) * LDP;
        f32x4 pt[8], o[8];
#pragma unroll
        for (int i = 0; i < 8; ++i) { pt[i] = (f32x4){0.f, 0.f, 0.f, 0.f}; o[i] = (f32x4){0.f, 0.f, 0.f, 0.f}; }
#pragma unroll
        for (int i = 0; i < 16; ++i) S[i] *= cd;
        bf16x8 vf[4];
#pragma unroll
        for (int half = 0; half < 2; ++half) {
            u32x4 sq[4], sk[4], sv[4];
#pragma unroll
            for (int k = 0; k < 4; ++k) { sq[k] = *(const u32x4*)(gc + (size_t)(32 * k) * LDP + 128 * half); sk[k] = *(const u32x4*)(gc + (size_t)(32 * k) * LDP + 1024 + 128 * half);
                if (half == 0) sv[k] = *(const u32x4*)(gc + (size_t)(32 * k) * LDP + 2048 + 128 * eh); }
            __syncthreads();
#pragma unroll
            for (int k = 0; k < 4; ++k) { *(RLAS u32x4*)(lds + QBO + stw + 8192 * k) = sq[k]; *(RLAS u32x4*)(lds + KBO + stw + 8192 * k) = sk[k];
                if (half == 0) *(RLAS u32x4*)(lds + VBO + stw + 8192 * k) = sv[k]; }
            __syncthreads();
            if (half == 0 && n < 15) {
                const bf16* nx = Pq + (size_t)(128 * (n + 1) + (tid >> 2)) * LDP + (tid & 3) * 64;
                RLAS unsigned* junk = (RLAS unsigned*)(lds + 131072 + w * 256);
                __builtin_amdgcn_global_load_lds((const unsigned*)nx, junk, 4, 0, 0);
                __builtin_amdgcn_global_load_lds((const unsigned*)(nx + 1024), junk, 4, 0, 0);
                if (tid < 256) __builtin_amdgcn_global_load_lds((const unsigned*)(Pq + (size_t)(128 * (n + 1) + (tid >> 1)) * LDP + 2048 + 128 * eh + (tid & 1) * 64), junk, 4, 0, 0);
            }
            if (half == 0) {
                const unsigned va0 = lb + VBO + (trb[0] ^ (32u * w)), va1 = lb + VBO + (trb[1] ^ (32u * w));
                s16x4 l0, h0, l1, h1, l2, h2, l3, h3;
                RET_TR(l0, va0, 0); RET_TR(h0, va1, 0); RET_TR(l1, va0, 8192); RET_TR(h1, va1, 8192); RET_TR(l2, va0, 16384); RET_TR(h2, va1, 16384); RET_TR(l3, va0, 24576); RET_TR(h3, va1, 24576);
                RET_LW();
                vf[0] = (bf16x8){l0[0], l0[1], l0[2], l0[3], h0[0], h0[1], h0[2], h0[3]}; vf[1] = (bf16x8){l1[0], l1[1], l1[2], l1[3], h1[0], h1[1], h1[2], h1[3]};
                vf[2] = (bf16x8){l2[0], l2[1], l2[2], l2[3], h2[0], h2[1], h2[2], h2[3]}; vf[3] = (bf16x8){l3[0], l3[1], l3[2], l3[3], h3[0], h3[1], h3[2], h3[3]};
            }
#pragma unroll
            for (int s = 0; s < 4; ++s) {
                const unsigned ra = rowA ^ (64u * s);
                const bf16x8 ka = *(const RLAS bf16x8*)(lds + KBO + 4096 * w + ra);
#pragma unroll
                for (int ib = 0; ib < 8; ++ib) if (ib >= w) { const bf16x8 qb = *(const RLAS bf16x8*)(lds + QBO + 4096 * ib + ra); pt[ib] = RET_MFMA(ka, qb, pt[ib]); }
            }
#pragma unroll
            for (int s = 0; s < 4; ++s) {
                const f32x4 t0 = S[8 * half + 2 * s], t1 = S[8 * half + 2 * s + 1];
                const bf16x8 tf = mk8(cvtpk(t0[0], t0[1]), cvtpk(t0[2], t0[3]), cvtpk(t1[0], t1[1]), cvtpk(t1[2], t1[3]));
                const unsigned rb0 = rowB ^ (64u * s), rb1 = rb0 ^ 32u;
#pragma unroll
                for (int ib = 0; ib < 8; ++ib) { const u32x2 a0 = *(const RLAS u32x2*)(lds + QBO + 4096 * ib + rb0), a1 = *(const RLAS u32x2*)(lds + QBO + 4096 * ib + rb1);
                    o[ib] = RET_MFMA(tf, mk8(a0.x, a0.y, a1.x, a1.y), o[ib]); }
            }
#pragma unroll
            for (int dtl = 0; dtl < 8; ++dtl) {
                const unsigned ka0 = lb + KBO + (trb[0] ^ (32u * dtl)), ka1 = lb + KBO + (trb[1] ^ (32u * dtl));
                s16x4 l0, h0, l1, h1, l2, h2, l3, h3;
                RET_TR(l0, ka0, 0); RET_TR(h0, ka1, 0); RET_TR(l1, ka0, 8192); RET_TR(h1, ka1, 8192); RET_TR(l2, ka0, 16384); RET_TR(h2, ka1, 16384); RET_TR(l3, ka0, 24576); RET_TR(h3, ka1, 24576);
                RET_LW();
                f32x4 acc = S[8 * half + dtl];
                acc = RET_MFMA(((bf16x8){l0[0], l0[1], l0[2], l0[3], h0[0], h0[1], h0[2], h0[3]}), vf[0], acc);
                acc = RET_MFMA(((bf16x8){l1[0], l1[1], l1[2], l1[3], h1[0], h1[1], h1[2], h1[3]}), vf[1], acc);
                acc = RET_MFMA(((bf16x8){l2[0], l2[1], l2[2], l2[3], h2[0], h2[1], h2[2], h2[3]}), vf[2], acc);
                acc = RET_MFMA(((bf16x8){l3[0], l3[1], l3[2], l3[3], h3[0], h3[1], h3[2], h3[3]}), vf[3], acc);
                S[8 * half + dtl] = acc;
            }
        }
#pragma unroll
        for (int ib = 0; ib < 8; ++ib) {
            f32x4 v = pt[ib];
            if (ib < w) v = (f32x4){0.f, 0.f, 0.f, 0.f};
            else if (ib == w) {
#pragma unroll
                for (int r = 0; r < 4; ++r) if (4 * q + r > l15) v[r] = 0.f; }
            u32x2 pw; pw.x = cvtpk(v[0], v[1]); pw.y = cvtpk(v[2], v[3]);
            *(RLAS u32x2*)(lds + pwr + 4096 * ib) = pw;
        }
        __syncthreads();
#pragma unroll
        for (int ib = 0; ib < 8; ++ib)
#pragma unroll
            for (int ks = 0; ks <= ib / 2; ++ks) { const bf16x8 pb = *(const RLAS bf16x8*)(lds + PBO + 4096 * ib + (rowA ^ (64u * ks))); o[ib] = RET_MFMA(vf[ks], pb, o[ib]); }
        bf16* orow = Ho + (size_t)(128 * n + l15) * LDP + 16 * w + 4 * q;
#pragma unroll
        for (int ib = 0; ib < 8; ++ib) { u32x2 ow; ow.x = cvtpk(o[ib][0], o[ib][1]); ow.y = cvtpk(o[ib][2], o[ib][3]); *(u32x2*)(orow + (size_t)(16 * ib) * LDP) = ow; }
    }
    __syncthreads();
}
#undef RET_TR
#undef RET_LW
#undef RET_MFMA
#undef RLAS
}


namespace tg {
using pg8::bf16_t; using pg8::bf16x8; using pg8::f32x4; using pg8::u32x4; using pg8::HTB; using pg8::lds_byte; using pg8::stage_rc; using pg8::perm32;
constexpr int STG = 3 * HTB;
template <bool PERM, int LDA, int LDB, bool ENTRY_SYNC = true>
__device__ __forceinline__ void accum(PG8_LAS unsigned char* lds, int tid_in, const bf16_t* A_in, const bf16_t* Bt_in, int nk, f32x4 (&acc)[2][4][2]) {
    int tid = tid_in; const bf16_t* A = A_in; const bf16_t* Bt = Bt_in; asm volatile("" : "+v"(tid), "+s"(A), "+s"(Bt));
    const int wid = __builtin_amdgcn_readfirstlane(tid >> 6), lane = tid & 63, wr = wid >> 2, wc = wid & 3, fr = lane & 15, fq = lane >> 4;
    unsigned voffA[2], voffB[2];
#pragma unroll
    for (int i = 0; i < 2; ++i) { int R, C; stage_rc(tid * 16 + i * 8192, R, C); const int Rb = PERM ? ((R & ~31) + perm32(R & 31)) : R;
        voffA[i] = (unsigned)(R * LDA + C) * 2u; voffB[i] = (unsigned)(Rb * LDB + C) * 2u; }
    const unsigned ldsw = (unsigned)wid * 1024u;
    const int aoff = lds_byte(wr * 64 + fr, fq * 8), boff = lds_byte(wc * 32 + fr, fq * 8);
    constexpr size_t hstepB = (size_t)128 * LDB * 2;
#define TG_STAGE(bufoff, gbase, voff) do { _Pragma("unroll") for (int _i = 0; _i < 2; ++_i) \
        __builtin_amdgcn_global_load_lds((const unsigned*)((const char*)(gbase) + (voff)[_i]), (PG8_LAS unsigned*)(lds + (bufoff) + ldsw + _i * 8192), 16, 0, 0); } while (0)
#define TG_STAGE_ALL(so, kt) do { const char* a_ = (const char*)A + (size_t)(kt) * 128; const char* b_ = (const char*)Bt + (size_t)(kt) * 128; \
        TG_STAGE((so), a_, voffA); TG_STAGE((so) + HTB, b_, voffB); TG_STAGE((so) + 2 * HTB, b_ + hstepB, voffB); } while (0)
#define TG_COMPUTE(so) do { bf16x8 At[4][2], B0[2][2], B1[2][2]; \
        _Pragma("unroll") for (int m = 0; m < 4; ++m) _Pragma("unroll") for (int k = 0; k < 2; ++k) At[m][k] = *(const PG8_LAS bf16x8*)(lds + (so) + aoff + m * 2048 + k * 1024); \
        _Pragma("unroll") for (int n = 0; n < 2; ++n) _Pragma("unroll") for (int k = 0; k < 2; ++k) { B0[n][k] = *(const PG8_LAS bf16x8*)(lds + (so) + HTB + boff + n * 2048 + k * 1024); \
                                                                                                   B1[n][k] = *(const PG8_LAS bf16x8*)(lds + (so) + 2 * HTB + boff + n * 2048 + k * 1024); } \
        __builtin_amdgcn_s_setprio(1); \
        _Pragma("unroll") for (int m = 0; m < 4; ++m) _Pragma("unroll") for (int n = 0; n < 2; ++n) _Pragma("unroll") for (int k = 0; k < 2; ++k) { \
            acc[0][m][n] = __builtin_amdgcn_mfma_f32_16x16x32_bf16(B0[n][k], At[m][k], acc[0][m][n], 0, 0, 0); \
            acc[1][m][n] = __builtin_amdgcn_mfma_f32_16x16x32_bf16(B1[n][k], At[m][k], acc[1][m][n], 0, 0, 0); } \
        __builtin_amdgcn_s_setprio(0); } while (0)
    if constexpr (ENTRY_SYNC) { asm volatile("s_waitcnt vmcnt(0)" ::: "memory"); __syncthreads(); }
    TG_STAGE_ALL(0, 0); TG_STAGE_ALL(STG, 1);
    int s0 = 0, s1 = STG, s2 = 2 * STG;
#pragma unroll 1
    for (int kt = 0; kt < nk; ++kt) {
        if (kt + 1 < nk) asm volatile("s_waitcnt vmcnt(6)" ::: "memory"); else asm volatile("s_waitcnt vmcnt(0)" ::: "memory");
        __builtin_amdgcn_s_barrier();
        asm volatile("" ::: "memory");
        if (kt + 2 < nk) TG_STAGE_ALL(s2, kt + 2);
        TG_COMPUTE(s0);
        const int t_ = s0; s0 = s1; s1 = s2; s2 = t_;
    }
#undef TG_STAGE
#undef TG_STAGE_ALL
#undef TG_COMPUTE
}
__device__ __forceinline__ void accum_rt(PG8_LAS unsigned char* lds, int tid_in, const bf16_t* A_in, const bf16_t* Bt_in, int lda, int ldb, bool perm, int nk, f32x4 (&acc)[2][4][2]) {
    int tid = tid_in; const bf16_t* A = A_in; const bf16_t* Bt = Bt_in; asm volatile("" : "+v"(tid), "+s"(A), "+s"(Bt));
    const int wid = __builtin_amdgcn_readfirstlane(tid >> 6), lane = tid & 63, wr = wid >> 2, wc = wid & 3, fr = lane & 15, fq = lane >> 4;
    unsigned voffA, voffB;
    { int R, C; stage_rc(tid * 16, R, C); const int Rb = perm ? ((R & ~31) + perm32(R & 31)) : R; voffA = (unsigned)(R * lda + C) * 2u; voffB = (unsigned)(Rb * ldb + C) * 2u; }
    const size_t r64A = (size_t)64 * lda * 2, r64B = (size_t)64 * ldb * 2;
    const unsigned ldsw = (unsigned)wid * 1024u;
    const int aoff = lds_byte(wr * 64 + fr, fq * 8), boff = lds_byte(wc * 32 + fr, fq * 8);
    const size_t hstepB = (size_t)128 * ldb * 2;
#define TG_STAGE(bufoff, gbase, voff, r64) do { _Pragma("unroll") for (int _i = 0; _i < 2; ++_i) \
        __builtin_amdgcn_global_load_lds((const unsigned*)((const char*)(gbase) + (size_t)_i * (r64) + (voff)), (PG8_LAS unsigned*)(lds + (bufoff) + ldsw + _i * 8192), 16, 0, 0); } while (0)
#define TG_STAGE_ALL(so, kt) do { const char* a_ = (const char*)A + (size_t)(kt) * 128; const char* b_ = (const char*)Bt + (size_t)(kt) * 128; \
        TG_STAGE((so), a_, voffA, r64A); TG_STAGE((so) + HTB, b_, voffB, r64B); TG_STAGE((so) + 2 * HTB, b_ + hstepB, voffB, r64B); } while (0)
#define TG_BAR() do { asm volatile("" ::: "memory"); __builtin_amdgcn_s_barrier(); asm volatile("" ::: "memory"); } while (0)
    asm volatile("s_waitcnt vmcnt(0)" ::: "memory"); __syncthreads();
    TG_STAGE_ALL(0, 0); TG_STAGE_ALL(STG, 1);
    if (wr == 1) { asm volatile("s_waitcnt vmcnt(6)" ::: "memory"); TG_BAR(); }
    int s0 = 0, s1 = STG, s2 = 2 * STG;
#pragma unroll 1
    for (int kt = 0; kt < nk; ++kt) {
        if (kt + 1 < nk) asm volatile("s_waitcnt vmcnt(6)" ::: "memory"); else asm volatile("s_waitcnt vmcnt(0)" ::: "memory");
        TG_BAR();
        if (kt + 2 < nk) TG_STAGE_ALL(s2, kt + 2);
        bf16x8 At[4][2], B0[2][2], B1[2][2];
#pragma unroll
        for (int m = 0; m < 4; ++m)
#pragma unroll
            for (int k = 0; k < 2; ++k) At[m][k] = *(const PG8_LAS bf16x8*)(lds + s0 + aoff + m * 2048 + k * 1024);
#pragma unroll
        for (int n = 0; n < 2; ++n)
#pragma unroll
            for (int k = 0; k < 2; ++k) { B0[n][k] = *(const PG8_LAS bf16x8*)(lds + s0 + HTB + boff + n * 2048 + k * 1024); B1[n][k] = *(const PG8_LAS bf16x8*)(lds + s0 + 2 * HTB + boff + n * 2048 + k * 1024); }
        if (kt + 2 < nk) asm volatile("s_waitcnt vmcnt(6)" ::: "memory"); else asm volatile("s_waitcnt vmcnt(0)" ::: "memory");
        asm volatile("s_waitcnt lgkmcnt(0)" ::: "memory");
        TG_BAR();
        __builtin_amdgcn_s_setprio(1);
#pragma unroll
        for (int m = 0; m < 4; ++m)
#pragma unroll
            for (int n = 0; n < 2; ++n)
#pragma unroll
                for (int k = 0; k < 2; ++k) { acc[0][m][n] = __builtin_amdgcn_mfma_f32_16x16x32_bf16(B0[n][k], At[m][k], acc[0][m][n], 0, 0, 0);
                                              acc[1][m][n] = __builtin_amdgcn_mfma_f32_16x16x32_bf16(B1[n][k], At[m][k], acc[1][m][n], 0, 0, 0); }
        __builtin_amdgcn_s_setprio(0);
        const int t_ = s0; s0 = s1; s1 = s2; s2 = t_;
    }
    if (wr == 0) TG_BAR();
#undef TG_STAGE
#undef TG_STAGE_ALL
#undef TG_BAR
}
__device__ __forceinline__ void zero_acc(f32x4 (&acc)[2][4][2]) {
#pragma unroll
    for (int b = 0; b < 2; ++b)
#pragma unroll
        for (int m = 0; m < 4; ++m)
#pragma unroll
            for (int n = 0; n < 2; ++n) acc[b][m][n] = (f32x4){0.f, 0.f, 0.f, 0.f};
}
}

constexpr int NWAVES = 8;
constexpr int BATCH = 32, SEQ = 2048, DM = 1024, DEPTH = 4, INW = 11264;
constexpr int MTOK = BATCH * SEQ;
constexpr int NGRP = 2, MG = MTOK / NGRP;
constexpr float EPS = 1e-6f;
constexpr size_t MiB = 1u << 20;
constexpr size_t WS_CTL = 0, CTL_ZERO_BYTES = 1 * MiB;
constexpr size_t WS_MOD = 1 * MiB;
constexpr size_t WS_WIN = 4 * MiB;
constexpr size_t WS_WPA = 92 * MiB;
constexpr size_t WS_WPR = 96 * MiB;
constexpr size_t WS_WOUT = 104 * MiB;
constexpr size_t WS_LSE = 112 * MiB;
constexpr size_t WS_H = 116 * MiB, H_BYTES = 64 * MiB;
constexpr size_t WS_P = 244 * MiB;
constexpr size_t WS_END = WS_P + (size_t)MG * pg8::LDP * 2;
static_assert(WS_END <= 1024 * MiB, "workspace map");
constexpr int CW_BAR = 4096;
constexpr int RING_OFF = 0, RING_BYTES = 147456;
constexpr int SSQ_OFF = RING_BYTES, LDSCTL_OFF = SSQ_OFF + 4096, MISC_OFF = LDSCTL_OFF + 320;
constexpr int LDS_BYTES = 155648;

struct Args { const float* x; const float* c; const int* pos; const float* norm_w; const float* w_ada; const float* b_ada; const float* w_in; const float* gn_w;
              const float* w_pa; const float* w_pr; const float* w_out; const float* fnw; float* out; unsigned char* ws; int ph_lo, ph_hi, l_lo, l_hi, g_lo, g_hi; };
static_assert(sizeof(Args) == 14 * 8 + 6 * 4, "Args has no padding");

struct Frame {
    LAS unsigned char* lds;
    int tid, lane, wave, vcu, G, bx;
};
__device__ __forceinline__ Frame mkframe(int wave_id) {
    Frame F; extern __shared__ __attribute__((aligned(16))) unsigned char lds[];
    F.lds = (LAS unsigned char*)lds;
    unsigned z_ = 0u; asm volatile("" : "+v"(z_));
    const int ln = (int)__builtin_amdgcn_mbcnt_hi(~0u, __builtin_amdgcn_mbcnt_lo(~0u, z_));
    int bx = blockIdx.x, G = gridDim.x, wv = wave_id; asm volatile("" : "+s"(bx), "+s"(G), "+s"(wv));
    F.lane = ln; F.wave = wv; F.tid = wv * 64 + ln; F.G = G; F.bx = bx;
    F.vcu = (G % 8 == 0) ? (bx % 8) * (G / 8) + bx / 8 : bx;
    return F;
}
__device__ __forceinline__ float shx(int lane, float v, int m) { return __uint_as_float((unsigned)__builtin_amdgcn_ds_bpermute((lane ^ m) << 2, (int)__float_as_uint(v))); }
typedef const __attribute__((address_space(4))) Args* KArgs;
__device__ __forceinline__ KArgs kargs() { KArgs p = (KArgs)__builtin_amdgcn_kernarg_segment_ptr(); asm volatile("" : "+s"(p)); return p; }

__device__ __forceinline__ float wave_sum(int lane, float v) {
#pragma unroll
    for (int o = 1; o < 64; o <<= 1) v += shx(lane, v, o);
    return v;
}
__device__ __forceinline__ float blo(unsigned w) { return __uint_as_float(w << 16); }
__device__ __forceinline__ float bhi(unsigned w) { return __uint_as_float(w & 0xffff0000u); }
__device__ __forceinline__ float silu_f(float x) { return x / (1.0f + __expf(-x)); }

__device__ __forceinline__ void p0_transpose_item(const float* W, int K, int N, bf16* WT, LAS float* scr, int item, int lane) {
    const int nblk = N / 32, kb = item / nblk, nb = item % nblk, k0 = 64 * kb, n0 = 32 * nb;
#pragma unroll 8
    for (int i = 0; i < 32; ++i) { const int kk = 2 * i + (lane >> 5); scr[kk * 33 + (lane & 31)] = W[(size_t)(k0 + kk) * N + n0 + (lane & 31)]; }
    LDS_WAIT(); asm volatile("" ::: "memory");
    const int c = lane & 7;
#pragma unroll
    for (int j = 0; j < 4; ++j) { const int n = (lane >> 3) + 8 * j; const LAS float* s = scr + (8 * c) * 33 + n;
        v4u o; o.x = pk2(s[0 * 33], s[1 * 33]); o.y = pk2(s[2 * 33], s[3 * 33]); o.z = pk2(s[4 * 33], s[5 * 33]); o.w = pk2(s[6 * 33], s[7 * 33]);
        *(GAS v4u*)(WT + (size_t)(n0 + n) * K + k0 + 8 * c) = o; }
    LDS_WAIT(); asm volatile("" ::: "memory");
}
__device__ __forceinline__ void p0_mod_item(Frame& F, const float* cin, const float* w_ada, const float* b_ada, float* MOD, int item) {
    const int l = item / 48, n0 = (item % 48) * 64;
    LAS float* cact = (LAS float*)(F.lds + RING_OFF);
    for (int i = F.tid; i < BATCH * DM; i += NWAVES * 64) cact[i] = silu_f(cin[i]);
    LDS_WAIT(); __syncthreads();
    float acc[BATCH];
#pragma unroll
    for (int b = 0; b < BATCH; ++b) acc[b] = 0.f;
    const float* wp = w_ada + ((size_t)l * DM + F.wave * 128) * 3072 + n0 + F.lane;
    for (int k4 = 0; k4 < 32; ++k4) {
        const float w0 = wp[(size_t)(4 * k4 + 0) * 3072], w1 = wp[(size_t)(4 * k4 + 1) * 3072], w2 = wp[(size_t)(4 * k4 + 2) * 3072], w3 = wp[(size_t)(4 * k4 + 3) * 3072];
#pragma unroll
        for (int b = 0; b < BATCH; ++b) { const f32x4 cv = *(const LAS f32x4*)(cact + b * DM + F.wave * 128 + 4 * k4);
            acc[b] += cv.x * w0 + cv.y * w1 + cv.z * w2 + cv.w * w3; }
    }
    __syncthreads();
    LAS float* part = (LAS float*)(F.lds + RING_OFF);
#pragma unroll
    for (int b = 0; b < BATCH; ++b) part[(F.wave * BATCH + b) * 64 + F.lane] = acc[b];
    LDS_WAIT(); __syncthreads();
    for (int o = F.tid; o < BATCH * 64; o += NWAVES * 64) { const int b = o >> 6, cn = o & 63; float s = 0.f;
#pragma unroll
        for (int w = 0; w < NWAVES; ++w) s += part[(w * BATCH + b) * 64 + cn];
        MOD[((size_t)l * BATCH + b) * 3072 + n0 + cn] = s + b_ada[l * 3072 + n0 + cn]; }
    LDS_WAIT(); __syncthreads();
}
__device__ __forceinline__ void p0_prologue(Frame& F, KArgs a, unsigned char* ws) {
    if (F.bx < DEPTH * 48) p0_mod_item(F, a->c, a->w_ada, a->b_ada, (float*)(ws + WS_MOD), F.bx);
    LAS float* scr = (LAS float*)(F.lds + RING_OFF + F.wave * 16384);
    const int gw = F.vcu * NWAVES + F.wave, NGW = F.G * NWAVES;
    constexpr int I_IN = (DM / 64) * (INW / 32), I_PA = (512 / 64) * (DM / 32), I_PR = (DM / 64) * (DM / 32), I_L = I_IN + I_PA + 2 * I_PR;
    const float* w_in = a->w_in; const float* w_pa = a->w_pa; const float* w_pr = a->w_pr; const float* w_out = a->w_out;
    bf16* Win = (bf16*)(ws + WS_WIN); bf16* Wpa = (bf16*)(ws + WS_WPA); bf16* Wpr = (bf16*)(ws + WS_WPR); bf16* Wout = (bf16*)(ws + WS_WOUT);
    for (int it = gw; it < DEPTH * I_L; it += NGW) {
        const int l = it / I_L; int r = it % I_L;
        if (r < I_IN) { p0_transpose_item(w_in + (size_t)l * DM * INW, DM, INW, Win + (size_t)l * INW * DM, scr, r, F.lane); continue; } r -= I_IN;
        if (r < I_PA) { p0_transpose_item(w_pa + (size_t)l * 512 * DM, 512, DM, Wpa + (size_t)l * DM * 512, scr, r, F.lane); continue; } r -= I_PA;
        if (r < I_PR) { p0_transpose_item(w_pr + (size_t)l * DM * DM, DM, DM, Wpr + (size_t)l * DM * DM, scr, r, F.lane); continue; } r -= I_PR;
        p0_transpose_item(w_out + (size_t)l * DM * DM, DM, DM, Wout + (size_t)l * DM * DM, scr, r, F.lane);
    }
}
__device__ __forceinline__ void norm_phase(Frame& F, const float* xs, const float* nw, const float* MODl, bf16* H, int tok0) {
    const int gw = F.vcu * NWAVES + F.wave, NGW = F.G * NWAVES;
    for (int m = gw; m < MG; m += NGW) {
        const int tok = tok0 + m, b = tok >> 11;
        const float* mod = MODl + (size_t)b * 3072;
        const GAS f32x4* xr = (const GAS f32x4*)(xs + (size_t)tok * DM) + F.lane;
        f32x4 v[4]; float s = 0.f;
#pragma unroll
        for (int j = 0; j < 4; ++j) { v[j] = xr[64 * j]; s += (v[j].x * v[j].x + v[j].y * v[j].y) + (v[j].z * v[j].z + v[j].w * v[j].w); }
        const float rstd = 1.0f / sqrtf(wave_sum(F.lane, s) * (1.f / DM) + EPS);
        GAS unsigned long long* o8 = (GAS unsigned long long*)(H + (size_t)m * DM) + F.lane;
#pragma unroll
        for (int j = 0; j < 4; ++j) { const int c = 4 * F.lane + 256 * j;
            const f32x4 w = *(const f32x4*)(nw + c), sh = *(const f32x4*)(mod + c), sc = *(const f32x4*)(mod + 1024 + c);
            const f32x4 y = v[j] * rstd * w * (sc + 1.0f) + sh;
            o8[64 * j] = (unsigned long long)pk2(y.x, y.y) | ((unsigned long long)pk2(y.z, y.w) << 32); }
    }
}
__device__ __forceinline__ void final_norm_phase(Frame& F, float* out, const float* fnw) {
    const int gw = F.vcu * NWAVES + F.wave, NGW = F.G * NWAVES;
    for (int m = gw; m < MTOK; m += NGW) {
        GAS f32x4* xr = (GAS f32x4*)(out + (size_t)m * DM) + F.lane;
        f32x4 v[4]; float s = 0.f;
#pragma unroll
        for (int j = 0; j < 4; ++j) { v[j] = xr[64 * j]; s += (v[j].x * v[j].x + v[j].y * v[j].y) + (v[j].z * v[j].z + v[j].w * v[j].w); }
        const float rstd = 1.0f / sqrtf(wave_sum(F.lane, s) * (1.f / DM) + EPS);
#pragma unroll
        for (int j = 0; j < 4; ++j) { const f32x4 w = *(const f32x4*)(fnw + 4 * F.lane + 256 * j); xr[64 * j] = v[j] * rstd * w; }
    }
}
__device__ __forceinline__ void attn_naive_phase(Frame& F, bf16* P, float* LSE) {
    const int gtid = F.vcu * (NWAVES * 64) + F.tid, NT = F.G * NWAVES * 64;
    for (int it2 = gtid; it2 < 2 * 12 * MG; it2 += NT) {
        const int item = it2 >> 1, half = it2 & 1;
        const int hg = item / MG, n = item % MG, gi = hg >> 2, dsh = 2 * gi, Lsub = SEQ >> dsh;
        const int b = n >> 11, rem = n & 2047, r = rem >> (11 - dsh), m = rem & (Lsub - 1);
        const int row = b * SEQ + (m << dsh) + r;
        bf16* qp = P + (size_t)row * pg8::LDP + pg8::C_QA + hg * 128 + half * 64;
        v4u q[8];
#pragma unroll
        for (int i = 0; i < 8; ++i) q[i] = *(const GAS v4u*)(qp + 8 * i);
        float o[64];
#pragma unroll
        for (int i = 0; i < 64; ++i) o[i] = 0.f;
        float mrun = -1e30f, lsum = 0.f;
        const int mlo = m > 128 ? m - 128 : 0;
        for (int mk = mlo; mk <= m; ++mk) {
            const bf16* kp = P + (size_t)(b * SEQ + (mk << dsh) + r) * pg8::LDP + pg8::C_KA + hg * 128 + half * 64;
            float d0 = 0.f, d1 = 0.f;
#pragma unroll
            for (int i = 0; i < 8; ++i) { const v4u kv = *(const GAS v4u*)(kp + 8 * i);
                d0 += blo(q[i].x) * blo(kv.x) + blo(q[i].y) * blo(kv.y) + blo(q[i].z) * blo(kv.z) + blo(q[i].w) * blo(kv.w);
                d1 += bhi(q[i].x) * bhi(kv.x) + bhi(q[i].y) * bhi(kv.y) + bhi(q[i].z) * bhi(kv.z) + bhi(q[i].w) * bhi(kv.w); }
            float dt = d0 + d1; dt += shx(F.lane, dt, 1);
            const float sc = dt * 0.08838834764831845f;
            const float mn = fmaxf(mrun, sc), al = __expf(mrun - mn), p = __expf(sc - mn);
            lsum = lsum * al + p; mrun = mn;
            const bf16* vp = kp + (pg8::C_VA - pg8::C_KA);
#pragma unroll
            for (int i = 0; i < 8; ++i) { const v4u vv = *(const GAS v4u*)(vp + 8 * i);
                o[8 * i + 0] = o[8 * i + 0] * al + p * blo(vv.x); o[8 * i + 1] = o[8 * i + 1] * al + p * bhi(vv.x);
                o[8 * i + 2] = o[8 * i + 2] * al + p * blo(vv.y); o[8 * i + 3] = o[8 * i + 3] * al + p * bhi(vv.y);
                o[8 * i + 4] = o[8 * i + 4] * al + p * blo(vv.z); o[8 * i + 5] = o[8 * i + 5] * al + p * bhi(vv.z);
                o[8 * i + 6] = o[8 * i + 6] * al + p * blo(vv.w); o[8 * i + 7] = o[8 * i + 7] * al + p * bhi(vv.w); }
        }
        const float inv = 1.0f / lsum;
#pragma unroll
        for (int i = 0; i < 8; ++i) { v4u w; w.x = pk2(o[8 * i] * inv, o[8 * i + 1] * inv); w.y = pk2(o[8 * i + 2] * inv, o[8 * i + 3] * inv);
            w.z = pk2(o[8 * i + 4] * inv, o[8 * i + 5] * inv); w.w = pk2(o[8 * i + 6] * inv, o[8 * i + 7] * inv); *(GAS v4u*)(qp + 8 * i) = w; }
        if (half == 0) LSE[(size_t)row * 12 + hg] = mrun + __logf(lsum);
    }
}
__device__ __forceinline__ att::BlockRef attn_ref(int L, bf16* P, float* LSE) {
    const int blk = L / 192, rem = L - blk * 192, b = rem / 12, hg = rem - b * 12, g = hg >> 2;
    att::BlockRef r; int r0;
    if (g == 0) { r0 = 0; r.P0 = blk * 256; r.dsh = 0; r.lmask = 0x7fffffff; r.lsh = 31; r.g2 = 0; }
    else if (g == 1) { r0 = blk >> 1; r.P0 = (blk & 1) * 256; r.dsh = 2; r.lmask = 0x7fffffff; r.lsh = 31; r.g2 = 0; }
    else { r0 = 2 * blk; r.P0 = 0; r.dsh = 4; r.lmask = 127; r.lsh = 7; r.g2 = 1; }
    const size_t rowbase = (size_t)b * SEQ + r0;
    bf16* q = P + rowbase * pg8::LDP + pg8::C_QA + hg * 128;
    r.Q = q; r.L = LSE + rowbase * 12 + hg;
    return r;
}
__device__ __forceinline__ void attn_phase(Frame& F, bf16* P, float* LSE, int L0, int step, int cnt, bool dry = false) {
    if (cnt <= 0) return;
    char* lds = (char*)F.lds + RING_OFF;
    int L = L0, k = 0;
    att::BlockRef cur = attn_ref(L, P, LSE); att::Seam S;
    att::swa_prime(cur, lds, S, F.tid);
    for (;;) {
        const bool last = (k + 1 >= cnt);
        const att::BlockRef nxt = last ? cur : attn_ref(L + step, P, LSE);
        att::swa_block(cur, nxt, lds, S, F.tid, dry);
        if (last) break;
        cur = nxt; L += step; ++k;
    }
}
__device__ __forceinline__ void mix_phase(Frame& F, bf16* P, bf16* H, float* LSE) {
    constexpr int NRU = (MG / SEQ) * 4 * 2, NAB = 12 * (MG / SEQ) * 8;
    static_assert(NRU == 128 && NAB == 12 * 128, "mixer dealing is written for a 256-workgroup grid");
    if (F.G != 256) {
#if !RET_NAIVE
        for (int u = F.bx; u < NRU; u += F.G) { const int b = u >> 3, h = (u >> 1) & 3, eh = u & 1;
            ret::ret_unit(F.lds + RING_OFF, F.tid, P + (size_t)b * SEQ * pg8::LDP + pg8::C_QR + h * 256, P + (size_t)b * SEQ * pg8::LDP + pg8::C_GR + h * 256 + eh * 128, eh, h); }
#endif
        attn_phase(F, P, LSE, F.bx, F.G, (NAB - F.bx + F.G - 1) / F.G);
        return;
    }
    const bool isret = (F.vcu & 3) < 2;
    const int u = (F.vcu >> 2) * 2 + (F.vcu & 1);
#if !RET_NAIVE
#if PROBE_SEL == 30
    if (F.wave == 0) ((volatile LAS unsigned long long*)(F.lds + MISC_OFF + 64))[0] = __builtin_amdgcn_s_memrealtime();
#endif
    if (isret) { const int b = u >> 3, h = (u >> 1) & 3, eh = u & 1;
        ret::ret_unit(F.lds + RING_OFF, F.tid, P + (size_t)b * SEQ * pg8::LDP + pg8::C_QR + h * 256, P + (size_t)b * SEQ * pg8::LDP + pg8::C_GR + h * 256 + eh * 128, eh, h); }
#if PROBE_SEL == 30
    if (F.wave == 0) { volatile LAS unsigned long long* p_ = (volatile LAS unsigned long long*)(F.lds + MISC_OFF + 64); const unsigned long long v_ = p_[1] + (__builtin_amdgcn_s_memrealtime() - p_[0]); p_[1] = v_; }
#endif
#endif
#if DUP_RET
    if (isret) { const int b = u >> 3, h = (u >> 1) & 3, eh = u & 1;
        ret::ret_unit(F.lds + RING_OFF, F.tid, P + (size_t)b * SEQ * pg8::LDP + pg8::C_QR + h * 256, P + (size_t)b * SEQ * pg8::LDP + pg8::C_GR + h * 256 + eh * 128, eh, h); }
#endif
#if DUP_ATT
    { int dflag = 1; asm volatile("" : "+s"(dflag)); if (!isret) attn_phase(F, P, LSE, u, 128, 12, dflag != 0); }
#endif
    if (!isret) attn_phase(F, P, LSE, u, 128, 12);
}
__device__ __forceinline__ void ret_naive_phase(Frame& F, const bf16* P, bf16* H) {
    const int gtid = F.vcu * (NWAVES * 64) + F.tid, NT = F.G * NWAVES * 64;
    for (int it4 = gtid; it4 < 4 * 4 * MG; it4 += NT) {
        const int it0 = __builtin_amdgcn_readfirstlane(it4) >> 2;
        const int h = it0 / MG, n0 = it0 % MG, b = n0 >> 11, s0 = n0 & 2047, s = s0 + (F.lane >> 2), qd = F.lane & 3;
        const int row = b * SEQ + s;
        const float lg = __builtin_log2f(1.0f - __builtin_amdgcn_exp2f(-5.0f - (float)h));
        const bf16* qp = P + (size_t)row * pg8::LDP + pg8::C_QR + h * 256 + qd * 64;
        v4u q[8];
#pragma unroll
        for (int i = 0; i < 8; ++i) q[i] = *(const GAS v4u*)(qp + 8 * i);
        float o[64];
#pragma unroll
        for (int i = 0; i < 64; ++i) o[i] = 0.f;
        const int ci = s >> 7;
        for (int j = 0; j <= s0 + 15; ++j) {
            const bf16* kp = P + (size_t)(b * SEQ + j) * pg8::LDP + pg8::C_KR + h * 256 + qd * 64;
            float d0 = 0.f, d1 = 0.f;
#pragma unroll
            for (int i = 0; i < 8; ++i) { const v4u kv = *(const GAS v4u*)(kp + 8 * i);
                d0 += blo(q[i].x) * blo(kv.x) + blo(q[i].y) * blo(kv.y) + blo(q[i].z) * blo(kv.z) + blo(q[i].w) * blo(kv.w);
                d1 += bhi(q[i].x) * bhi(kv.x) + bhi(q[i].y) * bhi(kv.y) + bhi(q[i].z) * bhi(kv.z) + bhi(q[i].w) * bhi(kv.w); }
            float dt = d0 + d1; dt += shx(F.lane, dt, 1); dt += shx(F.lane, dt, 2);
            float w = dt * __builtin_amdgcn_exp2f((float)(128 * (ci - (j >> 7))) * lg);
            if (j > s) w = 0.f;
            const bf16* vp = kp + (pg8::C_VR - pg8::C_KR);
#pragma unroll
            for (int i = 0; i < 8; ++i) { const v4u vv = *(const GAS v4u*)(vp + 8 * i);
                o[8 * i + 0] += w * blo(vv.x); o[8 * i + 1] += w * bhi(vv.x); o[8 * i + 2] += w * blo(vv.y); o[8 * i + 3] += w * bhi(vv.y);
                o[8 * i + 4] += w * blo(vv.z); o[8 * i + 5] += w * bhi(vv.z); o[8 * i + 6] += w * blo(vv.w); o[8 * i + 7] += w * bhi(vv.w); }
        }
        bf16* op = H + (size_t)row * DM + h * 256 + qd * 64;
#pragma unroll
        for (int i = 0; i < 8; ++i) { v4u w; w.x = pk2(o[8 * i], o[8 * i + 1]); w.y = pk2(o[8 * i + 2], o[8 * i + 3]); w.z = pk2(o[8 * i + 4], o[8 * i + 5]); w.w = pk2(o[8 * i + 6], o[8 * i + 7]);
            *(GAS v4u*)(op + 8 * i) = w; }
    }
}
__device__ __forceinline__ void combine_phase(Frame& F, bf16* P, const bf16* H, const float* LSE, const float* gnw) {
    const int gw = F.vcu * NWAVES + F.wave, NGW = F.G * NWAVES, L = F.lane;
    for (int m = gw; m < MG; m += NGW) {
        bf16* pr = P + (size_t)m * pg8::LDP;
        {
            const int j = L >> 4, c0 = 8 * L, d0 = c0 & 127;
            const float l0 = LSE[(size_t)m * 12 + j], l1 = LSE[(size_t)m * 12 + 4 + j], l2 = LSE[(size_t)m * 12 + 8 + j];
            const float mx = fmaxf(l0, fmaxf(l1, l2));
            float e0 = __expf(l0 - mx), e1 = __expf(l1 - mx), e2 = __expf(l2 - mx);
            const float inv = 1.0f / (e0 + e1 + e2); e0 *= inv; e1 *= inv; e2 *= inv;
            const v4u a0 = *(const GAS v4u*)(pr + pg8::C_QA + (0 + j) * 128 + d0), a1 = *(const GAS v4u*)(pr + pg8::C_QA + (4 + j) * 128 + d0), a2 = *(const GAS v4u*)(pr + pg8::C_QA + (8 + j) * 128 + d0);
            const v4u z = *(const GAS v4u*)(pr + pg8::C_ZA + c0);
            v4u w;
#define CMB2(f) pk2((e0 * blo(a0.f) + e1 * blo(a1.f) + e2 * blo(a2.f)) * blo(z.f), (e0 * bhi(a0.f) + e1 * bhi(a1.f) + e2 * bhi(a2.f)) * bhi(z.f))
            w.x = CMB2(x); w.y = CMB2(y); w.z = CMB2(z); w.w = CMB2(w);
#undef CMB2
            *(GAS v4u*)(pr + pg8::C_ZA + c0) = w;
        }
        {
            const int c0 = 16 * L;
            const v4u u0 = *(const GAS v4u*)(H + (size_t)m * DM + c0), u1 = *(const GAS v4u*)(H + (size_t)m * DM + c0 + 8);
            float v[16] = {blo(u0.x), bhi(u0.x), blo(u0.y), bhi(u0.y), blo(u0.z), bhi(u0.z), blo(u0.w), bhi(u0.w), blo(u1.x), bhi(u1.x), blo(u1.y), bhi(u1.y), blo(u1.z), bhi(u1.z), blo(u1.w), bhi(u1.w)};
            float s = 0.f;
#pragma unroll
            for (int i = 0; i < 16; ++i) s += v[i];
            s += shx(L, s, 1); s += shx(L, s, 2); s += shx(L, s, 4); s += shx(L, s, 8);
            const float mu = s * (1.0f / 256.0f); float q = 0.f;
#pragma unroll
            for (int i = 0; i < 16; ++i) { v[i] -= mu; q += v[i] * v[i]; }
            q += shx(L, q, 1); q += shx(L, q, 2); q += shx(L, q, 4); q += shx(L, q, 8);
            const float rstd = 1.0f / sqrtf(q * (1.0f / 256.0f) + EPS);
            const v4u z0 = *(const GAS v4u*)(pr + pg8::C_ZR + c0), z1 = *(const GAS v4u*)(pr + pg8::C_ZR + c0 + 8);
            const float zz[16] = {blo(z0.x), bhi(z0.x), blo(z0.y), bhi(z0.y), blo(z0.z), bhi(z0.z), blo(z0.w), bhi(z0.w), blo(z1.x), bhi(z1.x), blo(z1.y), bhi(z1.y), blo(z1.z), bhi(z1.z), blo(z1.w), bhi(z1.w)};
            float y[16];
#pragma unroll
            for (int i = 0; i < 4; ++i) { const f32x4 g = *(const f32x4*)(gnw + c0 + 4 * i);
                y[4 * i] = v[4 * i] * rstd * g.x * zz[4 * i]; y[4 * i + 1] = v[4 * i + 1] * rstd * g.y * zz[4 * i + 1]; y[4 * i + 2] = v[4 * i + 2] * rstd * g.z * zz[4 * i + 2]; y[4 * i + 3] = v[4 * i + 3] * rstd * g.w * zz[4 * i + 3]; }
            v4u w0, w1; w0.x = pk2(y[0], y[1]); w0.y = pk2(y[2], y[3]); w0.z = pk2(y[4], y[5]); w0.w = pk2(y[6], y[7]); w1.x = pk2(y[8], y[9]); w1.y = pk2(y[10], y[11]); w1.z = pk2(y[12], y[13]); w1.w = pk2(y[14], y[15]);
            *(GAS v4u*)(pr + pg8::C_ZR + c0) = w0; *(GAS v4u*)(pr + pg8::C_ZR + c0 + 8) = w1;
        }
    }
}

__device__ __forceinline__ void wg_rewrite_fence() {
    asm volatile("s_waitcnt vmcnt(0) lgkmcnt(0)" ::: "memory"); __syncthreads();
}
__device__ __forceinline__ void combine_rows(Frame& F, bf16* P, const bf16* H, const float* LSE, const float* gnw, int r0, int nrows, int wave_lin, int nwaves) {
    const int L = F.lane;
    constexpr int R = 4;
    {
        const int j = L >> 4, c0 = 8 * L, d0 = c0 & 127;
        for (int m0 = r0 + R * wave_lin; m0 < r0 + nrows; m0 += R * nwaves) {
            v4u a0[R], a1[R], a2[R], z[R]; float l0[R], l1[R], l2[R];
#pragma unroll
            for (int i = 0; i < R; ++i) { const bf16* pr = P + (size_t)(m0 + i) * pg8::LDP; const float* ls = LSE + (size_t)(m0 + i) * 12 + j;
                l0[i] = ls[0]; l1[i] = ls[4]; l2[i] = ls[8];
                a0[i] = *(const GAS v4u*)(pr + pg8::C_QA + (0 + j) * 128 + d0); a1[i] = *(const GAS v4u*)(pr + pg8::C_QA + (4 + j) * 128 + d0); a2[i] = *(const GAS v4u*)(pr + pg8::C_QA + (8 + j) * 128 + d0);
                z[i] = *(const GAS v4u*)(pr + pg8::C_ZA + c0); }
#pragma unroll
            for (int i = 0; i < R; ++i) {
                const float mx = fmaxf(l0[i], fmaxf(l1[i], l2[i]));
                float e0 = __expf(l0[i] - mx), e1 = __expf(l1[i] - mx), e2 = __expf(l2[i] - mx);
                const float inv = 1.0f / (e0 + e1 + e2); e0 *= inv; e1 *= inv; e2 *= inv;
                v4u w;
#define CMB2(f) pk2((e0 * blo(a0[i].f) + e1 * blo(a1[i].f) + e2 * blo(a2[i].f)) * blo(z[i].f), (e0 * bhi(a0[i].f) + e1 * bhi(a1[i].f) + e2 * bhi(a2[i].f)) * bhi(z[i].f))
                w.x = CMB2(x); w.y = CMB2(y); w.z = CMB2(z); w.w = CMB2(w);
#undef CMB2
                *(GAS v4u*)(P + (size_t)(m0 + i) * pg8::LDP + pg8::C_ZA + c0) = w; }
        }
    }
    {
        const int c0 = 16 * L;
        f32x4 g[4];
#pragma unroll
        for (int i = 0; i < 4; ++i) g[i] = *(const f32x4*)(gnw + c0 + 4 * i);
        for (int m0 = r0 + R * wave_lin; m0 < r0 + nrows; m0 += R * nwaves) {
            v4u u0[R], u1[R], z0[R], z1[R];
#pragma unroll
            for (int i = 0; i < R; ++i) { const bf16* pr = P + (size_t)(m0 + i) * pg8::LDP; const bf16* hr = pr + pg8::C_GR + c0;
                u0[i] = *(const GAS v4u*)(hr); u1[i] = *(const GAS v4u*)(hr + 8); z0[i] = *(const GAS v4u*)(pr + pg8::C_ZR + c0); z1[i] = *(const GAS v4u*)(pr + pg8::C_ZR + c0 + 8); }
#pragma unroll
            for (int i = 0; i < R; ++i) {
                float v[16] = {blo(u0[i].x), bhi(u0[i].x), blo(u0[i].y), bhi(u0[i].y), blo(u0[i].z), bhi(u0[i].z), blo(u0[i].w), bhi(u0[i].w), blo(u1[i].x), bhi(u1[i].x), blo(u1[i].y), bhi(u1[i].y), blo(u1[i].z), bhi(u1[i].z), blo(u1[i].w), bhi(u1[i].w)};
                float sm = 0.f;
#pragma unroll
                for (int k = 0; k < 16; ++k) sm += v[k];
                sm += shx(L, sm, 1); sm += shx(L, sm, 2); sm += shx(L, sm, 4); sm += shx(L, sm, 8);
                const float mu = sm * (1.0f / 256.0f); float q = 0.f;
#pragma unroll
                for (int k = 0; k < 16; ++k) { v[k] -= mu; q += v[k] * v[k]; }
                q += shx(L, q, 1); q += shx(L, q, 2); q += shx(L, q, 4); q += shx(L, q, 8);
                const float rstd = 1.0f / sqrtf(q * (1.0f / 256.0f) + EPS);
                const float zz[16] = {blo(z0[i].x), bhi(z0[i].x), blo(z0[i].y), bhi(z0[i].y), blo(z0[i].z), bhi(z0[i].z), blo(z0[i].w), bhi(z0[i].w), blo(z1[i].x), bhi(z1[i].x), blo(z1[i].y), bhi(z1[i].y), blo(z1[i].z), bhi(z1[i].z), blo(z1[i].w), bhi(z1[i].w)};
                float y[16];
#pragma unroll
                for (int k = 0; k < 4; ++k) { y[4 * k] = v[4 * k] * rstd * g[k].x * zz[4 * k]; y[4 * k + 1] = v[4 * k + 1] * rstd * g[k].y * zz[4 * k + 1]; y[4 * k + 2] = v[4 * k + 2] * rstd * g[k].z * zz[4 * k + 2]; y[4 * k + 3] = v[4 * k + 3] * rstd * g[k].w * zz[4 * k + 3]; }
                v4u w0, w1; w0.x = pk2(y[0], y[1]); w0.y = pk2(y[2], y[3]); w0.z = pk2(y[4], y[5]); w0.w = pk2(y[6], y[7]); w1.x = pk2(y[8], y[9]); w1.y = pk2(y[10], y[11]); w1.z = pk2(y[12], y[13]); w1.w = pk2(y[14], y[15]);
                bf16* pr = P + (size_t)(m0 + i) * pg8::LDP;
                *(GAS v4u*)(pr + pg8::C_ZR + c0) = w0; *(GAS v4u*)(pr + pg8::C_ZR + c0 + 8) = w1; }
        }
    }
}
#if PROBE_SEL >= 10
#define TP_START() do { if (wid == 0) ((volatile LAS unsigned long long*)(F.lds + MISC_OFF + 64))[0] = __builtin_amdgcn_s_memrealtime(); } while (0)
#define TP_END(k) do { if ((k) == PROBE_SEL && wid == 0) { volatile LAS unsigned long long* p_ = (volatile LAS unsigned long long*)(F.lds + MISC_OFF + 64); const unsigned long long v_ = p_[1] + (__builtin_amdgcn_s_memrealtime() - p_[0]); p_[1] = v_; } } while (0)
#else
#define TP_START() do { } while (0)
#define TP_END(k) do { } while (0)
#endif
__device__ __forceinline__ void tail_phase(Frame& F, bf16* P, bf16* H, const float* LSE, const float* gnw, const bf16* Win, const bf16* Wpa, const bf16* Wpr, const bf16* Wout,
                                           const float* xin, float* xout, const float* MODl  , const float* MODn  ,
                                           const float* nwn  , int tok0, bool last) {
    using pg8::f32x4; using pg8::u32x4; using pg8::LDP;
    LAS float* ssq = (LAS float*)(F.lds + SSQ_OFF);
    for (int pnl = F.bx; pnl < MG / 128; pnl += F.G) {
        unsigned zz_ = 0u; asm volatile("" : "+v"(zz_));
        const int lane_ = (int)__builtin_amdgcn_mbcnt_hi(~0u, __builtin_amdgcn_mbcnt_lo(~0u, zz_));
        const int lane = lane_, wid = F.wave, tid = wid * 64 + lane, wr = wid >> 2, wc = wid & 3, fr = lane & 15, fq = lane >> 4;
        const int r0 = pnl * 128, b = (tok0 + r0) >> 11;
        TP_START();
        { Frame F2 = F; F2.lane = lane; F2.tid = tid; combine_rows(F2, P, H, LSE, gnw, r0, 128, wid, NWAVES); }
        wg_rewrite_fence();
        TP_END(10); TP_START();
#pragma unroll 1
        for (int pn = 0; pn < 4; ++pn) {
            u32x4 tp[2][4], rp[2][4];
            const int col0 = pn * 256 + wc * 32 + 8 * fq;
#define TL_PACK(dst, E0, E1, E2, E3, E4, E5, E6, E7) dst = (u32x4){pg8::cvt_pk_bf16(E0, E1), pg8::cvt_pk_bf16(E2, E3), pg8::cvt_pk_bf16(E4, E5), pg8::cvt_pk_bf16(E6, E7)}
#pragma unroll 1
            for (int st = 0; st < 4; ++st) {
                const bf16* Ag = (st == 0 || st == 3) ? (const bf16*)(H + (size_t)r0 * DM) : (st == 1 ? (const bf16*)(P + (size_t)r0 * LDP + pg8::C_ZA) : (const bf16*)(P + (size_t)r0 * LDP + pg8::C_ZR));
                const bf16* Bg = st == 0 ? Win + (size_t)(9216 + pn * 256) * DM : st == 1 ? Wpa + (size_t)pn * 256 * 512 : st == 2 ? Wpr + (size_t)pn * 256 * DM : Win + (size_t)(10240 + pn * 256) * DM;
                const int lda = (st == 0 || st == 3) ? DM : LDP, ldb = st == 1 ? 512 : DM, nk = st == 1 ? 8 : 16;
                f32x4 aa[2][4][2]; tg::zero_acc(aa);
                tg::accum_rt(F.lds + RING_OFF, tid, Ag, Bg, lda, ldb, true, nk, aa);
                __builtin_amdgcn_sched_barrier(0);
                if (st == 0) {
#pragma unroll
                    for (int bj = 0; bj < 2; ++bj)
#pragma unroll
                        for (int m = 0; m < 4; ++m) { const f32x4 a0 = aa[bj][m][0], a1 = aa[bj][m][1];
                            TL_PACK(tp[bj][m], pg8::sigmoidf_(a0[0]), pg8::sigmoidf_(a0[1]), pg8::sigmoidf_(a0[2]), pg8::sigmoidf_(a0[3]), pg8::sigmoidf_(a1[0]), pg8::sigmoidf_(a1[1]), pg8::sigmoidf_(a1[2]), pg8::sigmoidf_(a1[3])); }
                } else if (st == 1) {
#pragma unroll
                    for (int bj = 0; bj < 2; ++bj)
#pragma unroll
                        for (int m = 0; m < 4; ++m) { const u32x4 g = tp[bj][m]; const f32x4 a0 = aa[bj][m][0], a1 = aa[bj][m][1];
                            TL_PACK(tp[bj][m], pg8::bf_lo(g.x) * a0[0], pg8::bf_hi(g.x) * a0[1], pg8::bf_lo(g.y) * a0[2], pg8::bf_hi(g.y) * a0[3], pg8::bf_lo(g.z) * a1[0], pg8::bf_hi(g.z) * a1[1], pg8::bf_lo(g.w) * a1[2], pg8::bf_hi(g.w) * a1[3]); }
                } else if (st == 2) {
#pragma unroll
                    for (int bj = 0; bj < 2; ++bj)
#pragma unroll
                        for (int m = 0; m < 4; ++m) { const f32x4 a0 = aa[bj][m][0], a1 = aa[bj][m][1]; TL_PACK(rp[bj][m], a0[0], a0[1], a0[2], a0[3], a1[0], a1[1], a1[2], a1[3]); }
                } else {
#pragma unroll
                    for (int m = 0; m < 4; ++m) { bf16* rowp = P + (size_t)(r0 + wr * 64 + m * 16 + fr) * LDP + col0;
#pragma unroll
                        for (int bj = 0; bj < 2; ++bj) { const u32x4 r = rp[bj][m], t = tp[bj][m]; const f32x4 c0 = aa[bj][m][0], c1 = aa[bj][m][1];
                            u32x4 w;
                            TL_PACK(w, pg8::bf_lo(t.x) + pg8::sigmoidf_(c0[0]) * pg8::bf_lo(r.x), pg8::bf_hi(t.x) + pg8::sigmoidf_(c0[1]) * pg8::bf_hi(r.x), pg8::bf_lo(t.y) + pg8::sigmoidf_(c0[2]) * pg8::bf_lo(r.y), pg8::bf_hi(t.y) + pg8::sigmoidf_(c0[3]) * pg8::bf_hi(r.y),
                                       pg8::bf_lo(t.z) + pg8::sigmoidf_(c1[0]) * pg8::bf_lo(r.z), pg8::bf_hi(t.z) + pg8::sigmoidf_(c1[1]) * pg8::bf_hi(r.z), pg8::bf_lo(t.w) + pg8::sigmoidf_(c1[2]) * pg8::bf_lo(r.w), pg8::bf_hi(t.w) + pg8::sigmoidf_(c1[3]) * pg8::bf_hi(r.w));
                            *(u32x4*)(rowp + pg8::C_GA + bj * 128) = w; } }
                }
                __builtin_amdgcn_sched_barrier(0);
            }
#undef TL_PACK
        }
        wg_rewrite_fence();
        TP_END(11); TP_START();
        float ss[4] = {0.f, 0.f, 0.f, 0.f};
#pragma unroll 1
        for (int pn = 0; pn < 4; ++pn) {
            f32x4 ac[2][4][2]; tg::zero_acc(ac);
            const int col0 = pn * 256 + wc * 32 + 4 * fq;
            tg::accum_rt(F.lds + RING_OFF, tid, P + (size_t)r0 * LDP + pg8::C_GA, Wout + (size_t)pn * 256 * DM, LDP, DM, false, 16, ac);
            f32x4 xv[4][2][2];
#pragma unroll
            for (int m = 0; m < 4; ++m) { const size_t off = (size_t)(tok0 + r0 + wr * 64 + m * 16 + fr) * DM + col0;
#pragma unroll
                for (int bj = 0; bj < 2; ++bj)
#pragma unroll
                    for (int n = 0; n < 2; ++n) xv[m][bj][n] = *(const f32x4*)(xin + off + bj * 128 + n * 16); }
            f32x4 gv[2][2];
#pragma unroll
            for (int bj = 0; bj < 2; ++bj)
#pragma unroll
                for (int n = 0; n < 2; ++n) gv[bj][n] = *(const f32x4*)(MODl + (size_t)b * 3072 + 2048 + col0 + bj * 128 + n * 16);
#pragma unroll
            for (int m = 0; m < 4; ++m) { const size_t off = (size_t)(tok0 + r0 + wr * 64 + m * 16 + fr) * DM + col0;
#pragma unroll
                for (int bj = 0; bj < 2; ++bj)
#pragma unroll
                    for (int n = 0; n < 2; ++n) { const f32x4 o = xv[m][bj][n] + gv[bj][n] * ac[bj][m][n];
                        *(f32x4*)(xout + off + bj * 128 + n * 16) = o; ss[m] += (o[0] * o[0] + o[1] * o[1]) + (o[2] * o[2] + o[3] * o[3]); } }
        }
        TP_END(12); TP_START();
#pragma unroll
        for (int m = 0; m < 4; ++m) { float s = ss[m]; s += shx(lane, s, 16); s += shx(lane, s, 32); if (fq == 0) ssq[wc * 128 + wr * 64 + m * 16 + fr] = s; }
        wg_rewrite_fence();
        if (tid < 128) ssq[512 + tid] = 1.0f / sqrtf((ssq[tid] + ssq[128 + tid] + ssq[256 + tid] + ssq[384 + tid]) * (1.0f / DM) + EPS);
        LDS_WAIT(); __syncthreads();
        {   f32x4 wv[4], shv[4], scv[4];
#pragma unroll
            for (int j = 0; j < 4; ++j) { const int c = 4 * lane + 256 * j; wv[j] = *(const f32x4*)(nwn + c);
                if (!last) { shv[j] = *(const f32x4*)(MODn + (size_t)b * 3072 + c); scv[j] = *(const f32x4*)(MODn + (size_t)b * 3072 + 1024 + c) + 1.0f; wv[j] = wv[j] * scv[j]; } }
            for (int rr = 4 * wid; rr < 128; rr += 4 * NWAVES) {
                f32x4 xr[4][4];
#pragma unroll
                for (int i = 0; i < 4; ++i)
#pragma unroll
                    for (int j = 0; j < 4; ++j) xr[i][j] = ((const GAS f32x4*)(xout + (size_t)(tok0 + r0 + rr + i) * DM) + lane)[64 * j];
#pragma unroll
                for (int i = 0; i < 4; ++i) { const float rstd = ssq[512 + rr + i];
                    if (last) { GAS f32x4* xo = (GAS f32x4*)(xout + (size_t)(tok0 + r0 + rr + i) * DM) + lane;
#pragma unroll
                        for (int j = 0; j < 4; ++j) xo[64 * j] = xr[i][j] * rstd * wv[j]; }
                    else { GAS unsigned long long* o8 = (GAS unsigned long long*)(H + (size_t)(r0 + rr + i) * DM) + lane;
#pragma unroll
                        for (int j = 0; j < 4; ++j) { const f32x4 y = xr[i][j] * rstd * wv[j] + shv[j];
                            o8[64 * j] = (unsigned long long)pk2(y.x, y.y) | ((unsigned long long)pk2(y.z, y.w) << 32); } } }
            }
        }
        LDS_WAIT(); __syncthreads();
        TP_END(13);
    }
}

__global__ void __launch_bounds__(NWAVES * 64, 2) fwd_kernel(Args a_unused) {
    extern __shared__ __attribute__((aligned(16))) unsigned char lds[];
    volatile LAS unsigned* MISC = (volatile LAS unsigned*)((LAS unsigned char*)lds + MISC_OFF);
    for (int u = threadIdx.x; u < (LDS_BYTES - LDSCTL_OFF) / 4; u += NWAVES * 64) ((LAS unsigned*)((LAS unsigned char*)lds + LDSCTL_OFF))[u] = 0u;
    __syncthreads();
    const int wave_id = __builtin_amdgcn_readfirstlane((int)threadIdx.x >> 6);
    KArgs a0 = kargs();
    const int ph_lo = a0->ph_lo, ph_hi = a0->ph_hi;
    const bool fused = (ph_hi - ph_lo) > 1;
    XcdBarrier bar; bar.bar = (unsigned*)(a0->ws + WS_CTL) + CW_BAR; bar.x = 0; bar.st = nullptr;
    if (fused) bar = xcd_barrier_post((unsigned*)(a0->ws + WS_CTL) + CW_BAR, MISC + 8);
#ifndef PH_MASK
#define PH_MASK 0x1ff
#endif
#define IN(k) (((PH_MASK >> (k)) & 1) && ph_lo <= (k) && (k) < ph_hi)
#define SEAM() do { if (fused) { XcdBarrier b2_ = bar; asm volatile("" : "+s"(b2_.bar)); xcd_barrier(b2_); } } while (0)

#if PROBE_SEL >= 0
    volatile LAS unsigned long long* pbw = (volatile LAS unsigned long long*)((LAS unsigned char*)lds + MISC_OFF + 64);
#define PB_START() do { if (wave_id == 0) pbw[0] = __builtin_amdgcn_s_memrealtime(); } while (0)
#define PB_END(k) do { if ((k) == PROBE_SEL && wave_id == 0) { const unsigned long long v_ = pbw[1] + (__builtin_amdgcn_s_memrealtime() - pbw[0]); pbw[1] = v_; } } while (0)
#else
#define PB_START() do { } while (0)
#define PB_END(k) do { } while (0)
#endif
    PB_START();
    if (IN(0)) { KArgs a = kargs(); Frame F = mkframe(wave_id); p0_prologue(F, a, a->ws); SEAM(); }
    PB_END(0);

    const int l_lo = a0->l_lo, l_hi = a0->l_hi, g_lo = a0->g_lo, g_hi = a0->g_hi;
    for (int l = l_lo; l < l_hi; ++l)
        for (int g = g_lo; g < g_hi; ++g) {
            const int tok0 = g * MG;
            PB_START();
            if (IN(1) && (!TAIL_FUSED || l == 0)) { KArgs a = kargs(); unsigned char* ws = a->ws; Frame F = mkframe(wave_id);
                norm_phase(F, (l == 0) ? a->x : a->out, a->norm_w + l * DM, (const float*)(ws + WS_MOD) + (size_t)l * BATCH * 3072, (bf16*)(ws + WS_H + g * H_BYTES), tok0); SEAM(); }
            PB_END(1); PB_START();
            if (IN(2)) { KArgs a = kargs(); unsigned char* ws = a->ws; Frame F = mkframe(wave_id);
                pg8::Gemm gm{(const bf16*)(ws + WS_H + g * H_BYTES), (const bf16*)(ws + WS_WIN) + (size_t)l * INW * DM}; pg8::StaticOrder S; S.init(MG, INW - 2048, F.G, F.bx);
                pg8::EpiProj E{(bf16*)(ws + WS_P), a->pos + tok0, tok0};
                pg8::gemm_phase<pg8::EpiProj, pg8::StaticOrder, true, true, DM, DM, DM>(F.lds + RING_OFF, F.tid, gm, S, E);
#if DUP_G1
                pg8::gemm_phase<pg8::EpiProj, pg8::StaticOrder, true, true, DM, DM, DM>(F.lds + RING_OFF, F.tid, gm, S, E);
#endif
                SEAM();
            }
            PB_END(2); PB_START();
            if (IN(3)) { KArgs a = kargs(); unsigned char* ws = a->ws; Frame F = mkframe(wave_id);
#if ATT_NAIVE
                attn_naive_phase(F, (bf16*)(ws + WS_P), (float*)(ws + WS_LSE));
#else
                mix_phase(F, (bf16*)(ws + WS_P), (bf16*)(ws + WS_H + g * H_BYTES), (float*)(ws + WS_LSE));
#endif
                SEAM(); }
#if RET_NAIVE
            if (IN(4)) { KArgs a = kargs(); unsigned char* ws = a->ws; Frame F = mkframe(wave_id); ret_naive_phase(F, (const bf16*)(ws + WS_P), (bf16*)(ws + WS_H + g * H_BYTES)); SEAM(); }
#endif
            PB_END(3); PB_START();
#if TAIL_FUSED
            if (IN(5)) { KArgs a = kargs(); unsigned char* ws = a->ws; Frame F = mkframe(wave_id);
                const bool lastl = (l == DEPTH - 1);
                tail_phase(F, (bf16*)(ws + WS_P), (bf16*)(ws + WS_H + g * H_BYTES), (const float*)(ws + WS_LSE), a->gn_w + l * DM, (const bf16*)(ws + WS_WIN) + (size_t)l * INW * DM,
                           (const bf16*)(ws + WS_WPA) + (size_t)l * DM * 512, (const bf16*)(ws + WS_WPR) + (size_t)l * DM * DM, (const bf16*)(ws + WS_WOUT) + (size_t)l * DM * DM,
                           (l == 0) ? a->x : a->out, a->out, (const float*)(ws + WS_MOD) + (size_t)l * BATCH * 3072, (const float*)(ws + WS_MOD) + (size_t)(lastl ? l : l + 1) * BATCH * 3072,
                           lastl ? a->fnw : a->norm_w + (l + 1) * DM, tok0, lastl);
                SEAM(); }
            PB_END(5);
#else
            if (IN(5)) { KArgs a = kargs(); unsigned char* ws = a->ws; Frame F = mkframe(wave_id); combine_phase(F, (bf16*)(ws + WS_P), (const bf16*)(ws + WS_H + g * H_BYTES), (const float*)(ws + WS_LSE), a->gn_w + l * DM); SEAM(); }
            if (IN(6)) {
                { KArgs a = kargs(); unsigned char* ws = a->ws; Frame F = mkframe(wave_id);
                  pg8::Gemm gm{(const bf16*)(ws + WS_P) + pg8::C_ZA, (const bf16*)(ws + WS_WPA) + (size_t)l * DM * 512}; pg8::StaticOrder S; S.init(MG, DM, F.G, F.bx);
                  pg8::EpiGate<0> E{(bf16*)(ws + WS_P)};
                  pg8::gemm_phase<pg8::EpiGate<0>, pg8::StaticOrder, true, true, 512, pg8::LDP, 512>(F.lds + RING_OFF, F.tid, gm, S, E); }
                { KArgs a = kargs(); unsigned char* ws = a->ws; Frame F = mkframe(wave_id);
                  pg8::Gemm gm{(const bf16*)(ws + WS_P) + pg8::C_ZR, (const bf16*)(ws + WS_WPR) + (size_t)l * DM * DM}; pg8::StaticOrder S; S.init(MG, DM, F.G, F.bx);
                  pg8::EpiGate<1> E{(bf16*)(ws + WS_P)};
                  pg8::gemm_phase<pg8::EpiGate<1>, pg8::StaticOrder, true, true, DM, pg8::LDP, DM>(F.lds + RING_OFF, F.tid, gm, S, E); }
                SEAM();
            }
            if (IN(7)) { KArgs a = kargs(); unsigned char* ws = a->ws; Frame F = mkframe(wave_id);
                pg8::Gemm gm{(const bf16*)(ws + WS_P) + pg8::C_GA, (const bf16*)(ws + WS_WOUT) + (size_t)l * DM * DM}; pg8::StaticOrder S; S.init(MG, DM, F.G, F.bx);
                pg8::EpiOut E{(l == 0) ? a->x : a->out, a->out, (const float*)(ws + WS_MOD) + (size_t)l * BATCH * 3072 + 2048, tok0};
                pg8::gemm_phase<pg8::EpiOut, pg8::StaticOrder, true, true, DM, pg8::LDP, DM>(F.lds + RING_OFF, F.tid, gm, S, E);
                SEAM();
            }
#endif
        }
#if PROBE_SEL >= 0
    if (blockIdx.x == 0 && wave_id == 0) { KArgs a = kargs(); asm volatile("s_waitcnt vmcnt(0)" ::: "memory"); const float v_ = a->out[0] + (float)pbw[1] * 1e-5f; a->out[0] = v_; }
#endif
    if (IN(8) && !TAIL_FUSED) { KArgs a = kargs(); Frame F = mkframe(wave_id); final_norm_phase(F, a->out, a->fnw); }
#undef IN
#undef SEAM
}

extern "C" void kernel_launch(void* const* d_in, const int* in_sizes, int n_in, void* d_out, int out_size, void* d_ws, size_t ws_size, hipStream_t stream) {
    static int grid = 0;
    if (grid == 0) {
        if (n_in != 12 || in_sizes[0] != MTOK * DM || out_size != MTOK * DM || ws_size < WS_END) { fprintf(stderr, "kernel_launch: unexpected shapes / workspace (n_in %d, ws %zu, need %zu)\n", n_in, ws_size, (size_t)WS_END); grid = -1; return; }
        int dev = 0, cus = 0, per_cu = 0;
        if (hipGetDevice(&dev) != hipSuccess || hipDeviceGetAttribute(&cus, hipDeviceAttributeMultiprocessorCount, dev) != hipSuccess) { grid = -1; return; }
        if (hipFuncSetAttribute((const void*)fwd_kernel, hipFuncAttributeMaxDynamicSharedMemorySize, LDS_BYTES) != hipSuccess) { fprintf(stderr, "kernel_launch: hipFuncSetAttribute failed\n"); grid = -1; return; }
        if (hipOccupancyMaxActiveBlocksPerMultiprocessor(&per_cu, (const void*)fwd_kernel, NWAVES * 64, LDS_BYTES) != hipSuccess || per_cu < 1) { fprintf(stderr, "kernel_launch: occupancy query says %d\n", per_cu); }
        (void)hipGetLastError();
        grid = cus;
    }
    if (grid < 0) return;
    (void)hipMemsetAsync((char*)d_ws + WS_CTL, 0, CTL_ZERO_BYTES, stream);
    Args a{};
    a.x = (const float*)d_in[0]; a.c = (const float*)d_in[1]; a.pos = (const int*)d_in[2]; a.norm_w = (const float*)d_in[3]; a.w_ada = (const float*)d_in[4]; a.b_ada = (const float*)d_in[5];
    a.w_in = (const float*)d_in[6]; a.gn_w = (const float*)d_in[7]; a.w_pa = (const float*)d_in[8]; a.w_pr = (const float*)d_in[9]; a.w_out = (const float*)d_in[10]; a.fnw = (const float*)d_in[11];
    a.out = (float*)d_out; a.ws = (unsigned char*)d_ws;
#if MK_FUSED
    a.ph_lo = 0; a.ph_hi = 9; a.l_lo = 0; a.l_hi = DEPTH; a.g_lo = 0; a.g_hi = NGRP;
    hipLaunchKernelGGL(fwd_kernel, dim3(grid), dim3(NWAVES * 64), LDS_BYTES, stream, a);
#else
    auto launch = [&](int ph, int l, int g) { a.ph_lo = ph; a.ph_hi = ph + 1; a.l_lo = l; a.l_hi = l + 1; a.g_lo = g; a.g_hi = g + 1;
        hipLaunchKernelGGL(fwd_kernel, dim3(grid), dim3(NWAVES * 64), LDS_BYTES, stream, a); };
    a.ph_lo = 0; a.ph_hi = 1; a.l_lo = 0; a.l_hi = 0; a.g_lo = 0; a.g_hi = 0;
    hipLaunchKernelGGL(fwd_kernel, dim3(grid), dim3(NWAVES * 64), LDS_BYTES, stream, a);
    for (int l = 0; l < DEPTH; ++l) for (int g = 0; g < NGRP; ++g) for (int ph = 1; ph <= 7; ++ph) launch(ph, l, g);
    a.ph_lo = 8; a.ph_hi = 9; a.l_lo = 0; a.l_hi = 0; a.g_lo = 0; a.g_hi = 0;
    hipLaunchKernelGGL(fwd_kernel, dim3(grid), dim3(NWAVES * 64), LDS_BYTES, stream, a);
#endif
    const hipError_t le = hipPeekAtLastError();
    if (le != hipSuccess) fprintf(stderr, "kernel_launch: launch failed: %s\n", hipGetErrorName(le));
}
```
